# Optimizing an MI355X kernel written in HIP

```python
import jax, jax.numpy as jnp
from jax import lax
import numpy as np

D_MODEL = 2048
BATCH = 2
SEQ = 16384
DEPTH = 2

GRID_W = 64
CTX_LEN = 256
HEAD_DIM = 128
HALF_DIM = HEAD_DIM // 2
AXIS_FREQS = HEAD_DIM // 4
ROPE_THETA = 10000.0
N_HEADS_A = 8
N_KV_A = 2
N_HEADS_B = 8
N_KV_B = 2
G_A = N_HEADS_A // N_KV_A
G_B = N_HEADS_B // N_KV_B
Q_BLOCK = 128
WINDOW = 128
BAND = Q_BLOCK + 2 * WINDOW
ATTN_SCALE = HEAD_DIM ** -0.5
NEG_INF = -1e30
Q_W = (N_HEADS_A + N_HEADS_B) * HEAD_DIM
KV_A_W = N_KV_A * HEAD_DIM
KV_B_W = N_KV_B * HEAD_DIM
KV_W = 2 * KV_A_W + 2 * KV_B_W
ATTN_WIDTH = Q_W
EVEN_IN = Q_W + KV_W + ATTN_WIDTH
POOL_WIDTH = D_MODEL
POOL_SIZES = (2, 4, 8, 16)
N_POOL_GROUPS = len(POOL_SIZES)
POOL_GROUP = POOL_WIDTH // N_POOL_GROUPS
ODD_IN = 2 * POOL_WIDTH
EPS = 1e-6
N_EVEN = (DEPTH + 1) // 2
N_ODD = DEPTH // 2

kernel_name = 'hybrid_dit_gqa_window_pool_prefix'


def _rmsnorm(x, g):
    xf = x.astype(jnp.float32)
    y = xf * lax.rsqrt(jnp.mean(xf * xf, axis=-1, keepdims=True) + EPS)
    return (y * g.astype(jnp.float32)).astype(x.dtype)


def _modulation(cvec, w, b):
    m = jax.nn.silu(cvec) @ w + b
    m = m[..., None, :]
    return m[..., :D_MODEL], m[..., D_MODEL:2 * D_MODEL], m[..., 2 * D_MODEL:]


def _axial_rope(rows):
    row = jnp.broadcast_to(jnp.arange(rows)[:, None], (rows, GRID_W)).reshape(-1).astype(jnp.float32)
    col = jnp.broadcast_to(jnp.arange(GRID_W)[None, :], (rows, GRID_W)).reshape(-1).astype(jnp.float32)
    inv = ROPE_THETA ** (-jnp.arange(AXIS_FREQS, dtype=jnp.float32) / AXIS_FREQS)
    ang = jnp.concatenate([row[:, None] * inv, col[:, None] * inv], axis=-1)
    return jnp.cos(ang), jnp.sin(ang)


def _rope(x, cos, sin):
    shape = (cos.shape[0],) + (1,) * (x.ndim - 3) + (cos.shape[1],)
    cos = cos.reshape(shape)
    sin = sin.reshape(shape)
    xf = x.astype(jnp.float32)
    x1, x2 = xf[..., :HALF_DIM], xf[..., HALF_DIM:]
    return jnp.concatenate([x1 * cos - x2 * sin, x2 * cos + x1 * sin], axis=-1).astype(x.dtype)


def _split_kv(kv):
    B, L = kv.shape[:2]
    kA = kv[..., :KV_A_W].reshape(B, L, N_KV_A, HEAD_DIM)
    vA = kv[..., KV_A_W:2 * KV_A_W].reshape(B, L, N_KV_A, HEAD_DIM)
    kB = kv[..., 2 * KV_A_W:2 * KV_A_W + KV_B_W].reshape(B, L, N_KV_B, HEAD_DIM)
    vB = kv[..., 2 * KV_A_W + KV_B_W:].reshape(B, L, N_KV_B, HEAD_DIM)
    return kA, vA, kB, vB


def _split_q(q):
    B, L = q.shape[:2]
    q = q.reshape(B, L, N_HEADS_A + N_HEADS_B, HEAD_DIM)
    qA = q[:, :, :N_HEADS_A].reshape(B, L, N_KV_A, G_A, HEAD_DIM)
    qB = q[:, :, N_HEADS_A:].reshape(B, L, N_KV_B, G_B, HEAD_DIM)
    return qA, qB


def _dense_attention(q, k, v):
    B, L = q.shape[:2]
    nb = L // Q_BLOCK

    def block(n):
        qb = lax.dynamic_slice_in_dim(q, n * Q_BLOCK, Q_BLOCK, axis=1)
        s = jnp.einsum('bqkgd,bskd->bkgqs', qb, k).astype(jnp.float32) * ATTN_SCALE
        p = jax.nn.softmax(s, axis=-1).astype(v.dtype)
        return jnp.einsum('bkgqs,bskd->bqkgd', p, v)

    o = lax.map(block, jnp.arange(nb))
    return jnp.moveaxis(o, 0, 1).reshape(B, L, -1)


def _window_attention(q, k, v, kc, vc, sink):
    B, L, KV, G, _ = q.shape
    C = kc.shape[1]
    nb = L // Q_BLOCK
    pad = ((0, 0), (WINDOW, WINDOW), (0, 0), (0, 0))
    kp = jnp.pad(k, pad)
    vp = jnp.pad(v, pad)
    sink_l = sink.astype(jnp.float32).reshape(1, KV, G, 1, 1)

    def block(n):
        start = n * Q_BLOCK
        qb = lax.dynamic_slice_in_dim(q, start, Q_BLOCK, axis=1)
        kb = lax.dynamic_slice_in_dim(kp, start, BAND, axis=1)
        vb = lax.dynamic_slice_in_dim(vp, start, BAND, axis=1)
        qpos = start + jnp.arange(Q_BLOCK)
        kpos = start - WINDOW + jnp.arange(BAND)
        valid = (jnp.abs(kpos[None, :] - qpos[:, None]) <= WINDOW) & (kpos >= 0)[None, :] & (kpos < L)[None, :]
        s_band = jnp.einsum('bqkgd,bjkd->bkgqj', qb, kb).astype(jnp.float32) * ATTN_SCALE
        s_band = jnp.where(valid, s_band, NEG_INF)
        s_ctx = jnp.einsum('bqkgd,bckd->bkgqc', qb, kc).astype(jnp.float32) * ATTN_SCALE
        s_sink = jnp.broadcast_to(sink_l, s_ctx.shape[:-1] + (1,))
        p = jax.nn.softmax(jnp.concatenate([s_band, s_ctx, s_sink], axis=-1), axis=-1).astype(v.dtype)
        return (jnp.einsum('bkgqj,bjkd->bqkgd', p[..., :BAND], vb)
                + jnp.einsum('bkgqc,bckd->bqkgd', p[..., BAND:BAND + C], vc))

    o = lax.map(block, jnp.arange(nb))
    return jnp.moveaxis(o, 0, 1).reshape(B, L, -1)


def _ctx_attention(q, k, v, sink=None):
    B, C = q.shape[:2]
    s = jnp.einsum('bqkgd,bckd->bkgqc', q, k).astype(jnp.float32) * ATTN_SCALE
    if sink is not None:
        KV, G = q.shape[2], q.shape[3]
        s_sink = jnp.broadcast_to(sink.astype(jnp.float32).reshape(1, KV, G, 1, 1), s.shape[:-1] + (1,))
        p = jax.nn.softmax(jnp.concatenate([s, s_sink], axis=-1), axis=-1)[..., :C]
    else:
        p = jax.nn.softmax(s, axis=-1)
    return jnp.einsum('bkgqc,bckd->bqkgd', p.astype(v.dtype), v).reshape(B, C, -1)


def _attention_layer(x, ctx, cos, sin, c, c_ctx, mod_w, mod_b, pre_g, post_g, w_in, q_norm, k_norm, sink, w_out, need_ctx_out):
    shift, scale, gate = _modulation(c, mod_w, mod_b)
    shift_c, scale_c, gate_c = _modulation(c_ctx, mod_w, mod_b)
    h = _rmsnorm(x, pre_g) * (1 + scale) + shift
    hc = _rmsnorm(ctx, pre_g) * (1 + scale_c) + shift_c

    proj = h @ w_in
    qA, qB = _split_q(proj[..., :Q_W])
    kA, vA, kB, vB = _split_kv(proj[..., Q_W:Q_W + KV_W])
    z = proj[..., Q_W + KV_W:]

    kA_c, vA_c, kB_c, vB_c = _split_kv(hc @ w_in[:, Q_W:Q_W + KV_W])
    kA_c = _rmsnorm(kA_c, k_norm)

    qA = _rope(_rmsnorm(qA, q_norm), cos, sin)
    kA = _rope(_rmsnorm(kA, k_norm), cos, sin)
    outA = _dense_attention(qA, jnp.concatenate([kA, kA_c], axis=1), jnp.concatenate([vA, vA_c], axis=1))

    outB = _window_attention(_rope(qB, cos, sin), _rope(kB, cos, sin), vB, kB_c, vB_c, sink)

    y = jnp.concatenate([outA, outB], axis=-1) * jax.nn.silu(z)
    x = x + gate * _rmsnorm(y @ w_out, post_g)

    if need_ctx_out:
        qA_c, qB_c = _split_q(hc @ w_in[:, :Q_W])
        z_c = hc @ w_in[:, Q_W + KV_W:]
        oA_c = _ctx_attention(_rmsnorm(qA_c, q_norm), kA_c, vA_c)
        oB_c = _ctx_attention(qB_c, kB_c, vB_c, sink)
        yc = jnp.concatenate([oA_c, oB_c], axis=-1) * jax.nn.silu(z_c)
        ctx = ctx + gate_c * _rmsnorm(yc @ w_out, post_g)
    return x, ctx


def _multiscale_pool(u, pool_w, pool_scale):
    B, L, _ = u.shape
    uf = u.astype(jnp.float32)
    cs = jnp.concatenate([jnp.zeros_like(uf[:, :1]), lax.cumsum(uf, axis=1)], axis=1)
    t = jnp.arange(L)
    outs = []
    for g, w in enumerate(POOL_SIZES):
        lo = jnp.clip(t - w // 2, 0, L)
        hi = jnp.clip(t + w // 2, 0, L)
        csg = cs[..., g * POOL_GROUP:(g + 1) * POOL_GROUP]
        mean = (jnp.take(csg, hi, axis=1) - jnp.take(csg, lo, axis=1)) / (hi - lo).astype(jnp.float32)[:, None]
        outs.append(mean - uf[..., g * POOL_GROUP:(g + 1) * POOL_GROUP])
    pooled = jnp.stack(outs, axis=2).astype(u.dtype)
    mixed = jnp.einsum('blgc,gcd->blgd', pooled, pool_w).reshape(B, L, POOL_WIDTH)
    return mixed * pool_scale


def _pool_layer(x, ctx, c, c_ctx, mod_w, mod_b, pre_g, post_g, w_in, pool_w, pool_scale, w_out, need_ctx_out):
    shift, scale, gate = _modulation(c, mod_w, mod_b)
    h = _rmsnorm(x, pre_g) * (1 + scale) + shift
    proj = h @ w_in
    y = _multiscale_pool(proj[..., :POOL_WIDTH], pool_w, pool_scale) * jax.nn.silu(proj[..., POOL_WIDTH:])
    x = x + gate * _rmsnorm(y @ w_out, post_g)
    if need_ctx_out:
        shift_c, scale_c, gate_c = _modulation(c_ctx, mod_w, mod_b)
        hc = _rmsnorm(ctx, pre_g) * (1 + scale_c) + shift_c
        pc = hc @ w_in
        yc = _multiscale_pool(pc[..., :POOL_WIDTH], pool_w, pool_scale) * jax.nn.silu(pc[..., POOL_WIDTH:])
        ctx = ctx + gate_c * _rmsnorm(yc @ w_out, post_g)
    return x, ctx


def setup_inputs(seed: int = 0) -> dict:
    key = jax.random.key(seed)
    ks = jax.random.split(key, 24)
    f32 = jnp.float32

    def nrm(k, shape, s):
        return jax.random.normal(k, shape, f32) * s

    return {
        'x': nrm(ks[0], (BATCH, SEQ, D_MODEL), 1.0),
        'c': nrm(ks[1], (BATCH, D_MODEL), 1.0),
        'ctx': nrm(ks[2], (BATCH, CTX_LEN, D_MODEL), 1.0),
        'c_ctx': nrm(ks[3], (D_MODEL,), 1.0),
        'ev_mod_w': nrm(ks[4], (N_EVEN, D_MODEL, 3 * D_MODEL), 0.5 * D_MODEL ** -0.5),
        'ev_mod_b': nrm(ks[5], (N_EVEN, 3 * D_MODEL), 0.02),
        'ev_pre_g': 1.0 + nrm(ks[6], (N_EVEN, D_MODEL), 0.05),
        'ev_post_g': 1.0 + nrm(ks[7], (N_EVEN, D_MODEL), 0.05),
        'ev_w_in': nrm(ks[8], (N_EVEN, D_MODEL, EVEN_IN), D_MODEL ** -0.5),
        'ev_q_norm': 1.0 + nrm(ks[9], (N_EVEN, HEAD_DIM), 0.05),
        'ev_k_norm': 1.0 + nrm(ks[10], (N_EVEN, HEAD_DIM), 0.05),
        'ev_sink': nrm(ks[11], (N_EVEN, N_HEADS_B), 0.5),
        'ev_w_out': nrm(ks[12], (N_EVEN, ATTN_WIDTH, D_MODEL), ATTN_WIDTH ** -0.5),
        'od_mod_w': nrm(ks[13], (N_ODD, D_MODEL, 3 * D_MODEL), 0.5 * D_MODEL ** -0.5),
        'od_mod_b': nrm(ks[14], (N_ODD, 3 * D_MODEL), 0.02),
        'od_pre_g': 1.0 + nrm(ks[15], (N_ODD, D_MODEL), 0.05),
        'od_post_g': 1.0 + nrm(ks[16], (N_ODD, D_MODEL), 0.05),
        'od_w_in': nrm(ks[17], (N_ODD, D_MODEL, ODD_IN), D_MODEL ** -0.5),
        'od_pool_w': nrm(ks[18], (N_ODD, N_POOL_GROUPS, POOL_GROUP, POOL_GROUP), POOL_GROUP ** -0.5),
        'od_pool_scale': 1.0 + nrm(ks[19], (N_ODD, POOL_WIDTH), 0.1),
        'od_w_out': nrm(ks[20], (N_ODD, POOL_WIDTH, D_MODEL), POOL_WIDTH ** -0.5),
    }


def reference(x, c, ctx, c_ctx, ev_mod_w, ev_mod_b, ev_pre_g, ev_post_g, ev_w_in, ev_q_norm, ev_k_norm, ev_sink, ev_w_out,
              od_mod_w, od_mod_b, od_pre_g, od_post_g, od_w_in, od_pool_w, od_pool_scale, od_w_out):
    ROWS = x.shape[1] // GRID_W
    cos, sin = _axial_rope(ROWS)
    for i in range(DEPTH):
        need_ctx_out = any(j % 2 == 0 for j in range(i + 1, DEPTH))
        if i % 2 == 0:
            e = i // 2
            x, ctx = _attention_layer(x, ctx, cos, sin, c, c_ctx, ev_mod_w[e], ev_mod_b[e], ev_pre_g[e], ev_post_g[e],
                                      ev_w_in[e], ev_q_norm[e], ev_k_norm[e], ev_sink[e], ev_w_out[e], need_ctx_out)
        else:
            o = i // 2
            x, ctx = _pool_layer(x, ctx, c, c_ctx, od_mod_w[o], od_mod_b[o], od_pre_g[o], od_post_g[o],
                                 od_w_in[o], od_pool_w[o], od_pool_scale[o], od_w_out[o], need_ctx_out)
    return x
```

```cpp
#include <hip/hip_runtime.h>
#include <hip/hip_cooperative_groups.h>
#include <cstdio>
#include <cstdint>
#include <cmath>
namespace cg = cooperative_groups;

#define LAS __attribute__((address_space(3)))
typedef unsigned short bf16_t;
typedef short bf16x8 __attribute__((ext_vector_type(8)));
typedef short s16x4 __attribute__((ext_vector_type(4)));
typedef float f32x4 __attribute__((ext_vector_type(4)));
typedef float f32x16 __attribute__((ext_vector_type(16)));
typedef unsigned u32x4 __attribute__((ext_vector_type(4)));
typedef unsigned u32x2 __attribute__((ext_vector_type(2)));

__device__ __forceinline__ unsigned cvt_pk_bf16(float lo, float hi) { unsigned r; asm volatile("v_cvt_pk_bf16_f32 %0, %1, %2" : "=v"(r) : "v"(lo), "v"(hi)); return r; }
__device__ __forceinline__ float bf_lo(unsigned w) { return __uint_as_float(w << 16); }
__device__ __forceinline__ float bf_hi(unsigned w) { return __uint_as_float(w & 0xffff0000u); }
__device__ __forceinline__ float bf2f(bf16_t h) { return __uint_as_float(((unsigned)h) << 16); }
__device__ __forceinline__ float silu_f(float v) { return v * __builtin_amdgcn_rcpf(1.f + __builtin_amdgcn_exp2f(-v * 1.4426950408889634f)); }

constexpr int DM = 2048, NB = 2, SEQ = 16384, CTX = 256, HD = 128;
constexpr int MLAT = NB * SEQ;
constexpr int MALL = MLAT + NB * CTX;
constexpr int EVEN_IN = 5120, ODD_IN = 4096;
constexpr int COL_Q = 0, COL_KA = 2048, COL_VA = 2304, COL_KB = 2560, COL_VB = 2816, COL_Z = 3072;
constexpr float EPS = 1e-6f;

namespace pg8 {
constexpr int BM = 256, BK = 64, HALF = 128, HTB = HALF * BK * 2, STAGE_BYTES = 8 * HTB, NXCD = 8, WGM = 8;
__host__ __device__ __forceinline__ int lds_byte(int r, int c) { const int st = (r >> 4) * 2 + (c >> 5), rr = r & 15, cc = c & 31, ob = rr * 64 + cc * 2; return st * 1024 + (ob ^ (((ob >> 9) & 1) << 5)); }
__host__ __device__ __forceinline__ void stage_rc(int b, int& R, int& C) { const int st = b / 1024, sb = b % 1024, swz = sb ^ (((sb >> 9) & 1) << 5); R = (st >> 1) * 16 + swz / 64; C = (st & 1) * 32 + (swz % 64) / 2; }
__host__ __device__ __forceinline__ int perm32(int rho) { const int n = rho >> 4, i = rho & 15; return 8 * (i >> 2) + 4 * n + (i & 3); }

struct Unit { int pm, pn; };
struct Gemm { const bf16_t* A; const bf16_t* Bt; int M, N, K, lda, ldb, gdiv; };

struct StaticOrder {
    int nM, nN, nwg, G, c;
    __host__ __device__ void init(int M, int N, int G_, int c_) { nM = M / BM; nN = N / BM; nwg = nM * nN; G = G_; c = c_; }
    __host__ __device__ bool next(int i, Unit& u) const {
        const long L = (long)i * G + c; if (L >= nwg) return false;
        int wgid = (int)L; { const int q = nwg / NXCD, r = nwg % NXCD, xcd = wgid % NXCD, off = wgid / NXCD; wgid = (xcd < r ? xcd * (q + 1) : r * (q + 1) + (xcd - r) * q) + off; }
        const int nig = WGM * nN, gid = wgid / nig, fm = gid * WGM, gsz = (nM - fm) < WGM ? (nM - fm) : WGM;
        u.pm = fm + ((wgid % nig) % gsz); u.pn = (wgid % nig) / gsz; return true;
    }
    __device__ __forceinline__ void a_ready(const Unit&) const {}
    __device__ __forceinline__ void done(const Unit&) const {}
};

struct EpiMk {
    static constexpr bool PERM = true, AFTER_DRAIN = false;
    bf16_t* O; int ldc; int silu_from; const float* cscale; const bf16_t* mul; int ldmul;
    __device__ __forceinline__ void operator()(const f32x4 (&acc)[2][2][4][2], const Unit& u, int wr, int wc, int fr, int fq) const {
        const int row0 = u.pm * BM + wr * 64 + fr; const int colt = u.pn * BM; const int col0 = colt + wc * 32 + 8 * fq;
        const bool dosilu = colt >= silu_from;
        f32x4 cs[2][2];
#pragma unroll
        for (int bj = 0; bj < 2; ++bj)
#pragma unroll
            for (int n = 0; n < 2; ++n) cs[bj][n] = cscale ? *(const f32x4*)(cscale + col0 + bj * HALF + 4 * n) : (f32x4){1.f, 1.f, 1.f, 1.f};
#pragma unroll
        for (int ai = 0; ai < 2; ++ai)
#pragma unroll
            for (int m = 0; m < 4; ++m) { const size_t row = (size_t)(row0 + ai * HALF + m * 16); bf16_t* rowp = O + row * ldc + col0;
#pragma unroll
                for (int bj = 0; bj < 2; ++bj) { f32x4 v0 = acc[ai][bj][m][0] * cs[bj][0], v1 = acc[ai][bj][m][1] * cs[bj][1];
                    if (mul) { const u32x4 mv = *(const u32x4*)(mul + row * ldmul + col0 + bj * HALF);
                        v0[0] *= bf_lo(mv.x); v0[1] *= bf_hi(mv.x); v0[2] *= bf_lo(mv.y); v0[3] *= bf_hi(mv.y); v1[0] *= bf_lo(mv.z); v1[1] *= bf_hi(mv.z); v1[2] *= bf_lo(mv.w); v1[3] *= bf_hi(mv.w); }
                    if (dosilu) {
#pragma unroll
                        for (int e = 0; e < 4; ++e) { v0[e] = silu_f(v0[e]); v1[e] = silu_f(v1[e]); } }
                    u32x4 w; w.x = cvt_pk_bf16(v0[0], v0[1]); w.y = cvt_pk_bf16(v0[2], v0[3]); w.z = cvt_pk_bf16(v1[0], v1[1]); w.w = cvt_pk_bf16(v1[2], v1[3]);
                    *(u32x4*)(rowp + bj * HALF) = w; } }
    }
};

#define PG8_LAS LAS
template <class Epi, class Sched, bool ALIGN_EPI = false, bool SP2 = false>
__device__ __forceinline__ void gemm_phase(PG8_LAS unsigned char* lds, const Gemm g, const Sched& S, const Epi& E) {
    const int tid = threadIdx.x, wid = __builtin_amdgcn_readfirstlane(tid >> 6), lane = tid & 63, wr = wid >> 2, wc = wid & 3, fr = lane & 15, fq = lane >> 4;
    const int K = g.K, nt = K / BK;
    unsigned voffA[2], voffB[2];
#pragma unroll
    for (int i = 0; i < 2; ++i) { int R, C; stage_rc(tid * 16 + i * 8192, R, C); const int Rb = Epi::PERM ? ((R & ~31) + perm32(R & 31)) : R;
        voffA[i] = (unsigned)(R * g.lda + C) * 2u; voffB[i] = (unsigned)(Rb * g.ldb + C) * 2u; }
    const size_t kstep = (size_t)(BK * 2);
    const size_t hstepA = (size_t)HALF * g.lda * 2, hstepB = (size_t)HALF * g.ldb * 2;
    const size_t tstepA = 2 * hstepA, tstepB = 2 * hstepB;
    const unsigned ldsw = (unsigned)wid * 1024u;
    const int aoff = lds_byte(wr * 64 + fr, fq * 8), boff = lds_byte(wc * 32 + fr, fq * 8);
#define PG8_SA(b, h) (((b) * 2 + (h)) * HTB)
#define PG8_SB(b, h) ((4 + (b) * 2 + (h)) * HTB)
#define PG8_STAGE(bufoff, gbase, voff) do { _Pragma("unroll") for (int _i = 0; _i < 2; ++_i) \
        __builtin_amdgcn_global_load_lds((const unsigned*)((const char*)(gbase) + (voff)[_i]), (PG8_LAS unsigned*)(lds + (bufoff) + ldsw + _i * 8192), 16, 0, 0); } while (0)
#define PG8_LDA(dst, b, h) do { _Pragma("unroll") for (int m = 0; m < 4; ++m) _Pragma("unroll") for (int k = 0; k < 2; ++k) dst[m][k] = *(const PG8_LAS bf16x8*)(lds + PG8_SA(b, h) + aoff + m * 2048 + k * 1024); } while (0)
#define PG8_LDB(dst, b, h) do { _Pragma("unroll") for (int n = 0; n < 2; ++n) _Pragma("unroll") for (int k = 0; k < 2; ++k) dst[n][k] = *(const PG8_LAS bf16x8*)(lds + PG8_SB(b, h) + boff + n * 2048 + k * 1024); } while (0)
#define PG8_MMA(ai, bj, At, Bt) do { __builtin_amdgcn_s_setprio(1); _Pragma("unroll") for (int m = 0; m < 4; ++m) _Pragma("unroll") for (int n = 0; n < 2; ++n) _Pragma("unroll") for (int k = 0; k < 2; ++k) \
        acc[ai][bj][m][n] = __builtin_amdgcn_mfma_f32_16x16x32_bf16(Bt[n][k], At[m][k], acc[ai][bj][m][n], 0, 0, 0); __builtin_amdgcn_s_setprio(0); } while (0)
#define PG8_WAIT_V(n) asm volatile("s_waitcnt vmcnt(" #n ")" ::: "memory")
#define PG8_WAIT_L(n) asm volatile("s_waitcnt lgkmcnt(" #n ")" ::: "memory")
#define PG8_BAR __builtin_amdgcn_s_barrier()
#define PG8_SCHED __builtin_amdgcn_sched_barrier(0)
    Unit cur, nxt; int ui = 0;
    if (!S.next(0, cur)) return;
    f32x4 acc[2][2][4][2];
#pragma unroll
    for (int a = 0; a < 2; ++a)
#pragma unroll
        for (int b = 0; b < 2; ++b)
#pragma unroll
            for (int m = 0; m < 4; ++m)
#pragma unroll
                for (int n = 0; n < 2; ++n) acc[a][b][m][n] = (f32x4){0.f, 0.f, 0.f, 0.f};
    bf16x8 At[4][2], B0[2][2], B1[2][2];
    const char* cA = (const char*)g.A + (size_t)cur.pm * tstepA + (size_t)(cur.pn / g.gdiv) * (size_t)K * 2; const char* cB = (const char*)g.Bt + (size_t)cur.pn * tstepB;
    S.a_ready(cur);
    if constexpr (SP2) {
        PG8_STAGE(PG8_SB(0, 0), cB, voffB); PG8_STAGE(PG8_SB(0, 1), cB + hstepB, voffB); PG8_STAGE(PG8_SA(0, 0), cA, voffA); PG8_STAGE(PG8_SA(0, 1), cA + hstepA, voffA);
        if (wr == 1) PG8_BAR;
        PG8_WAIT_V(2); PG8_BAR;
        PG8_STAGE(PG8_SB(1, 0), cB + kstep, voffB); PG8_STAGE(PG8_SA(1, 0), cA + kstep, voffA); PG8_STAGE(PG8_SB(1, 1), cB + hstepB + kstep, voffB);
        PG8_WAIT_V(6); PG8_BAR;
    } else {
        PG8_STAGE(PG8_SB(0, 0), cB, voffB); PG8_STAGE(PG8_SA(0, 0), cA, voffA); PG8_STAGE(PG8_SB(0, 1), cB + hstepB, voffB); PG8_STAGE(PG8_SA(0, 1), cA + hstepA, voffA);
        if (wr == 1) PG8_BAR;
        PG8_WAIT_V(4); PG8_BAR;
        PG8_STAGE(PG8_SB(1, 0), cB + kstep, voffB); PG8_STAGE(PG8_SA(1, 0), cA + kstep, voffA); PG8_STAGE(PG8_SB(1, 1), cB + hstepB + kstep, voffB);
        PG8_WAIT_V(6); PG8_BAR;
    }
    for (;;) {
        const bool has_next = S.next(ui + 1, nxt);
        const char* nA = has_next ? (const char*)g.A + (size_t)nxt.pm * tstepA + (size_t)(nxt.pn / g.gdiv) * (size_t)K * 2 : cA; const char* nB = has_next ? (const char*)g.Bt + (size_t)nxt.pn * tstepB : cB;
        for (int t = 0; t < nt; t += 2) {
            const bool last = (t == nt - 2);
            const char* a1 = cA + (size_t)(t + 1) * kstep;
            const char* a2 = last ? nA : cA + (size_t)(t + 2) * kstep; const char* b2 = last ? nB : cB + (size_t)(t + 2) * kstep;
            const char* a3 = a2 + kstep; const char* b3 = b2 + kstep;
            if (last && has_next) S.a_ready(nxt);
            if constexpr (SP2) {
            PG8_LDB(B0, 0, 0); PG8_LDB(B1, 0, 1); PG8_SCHED; PG8_LDA(At, 0, 0); PG8_STAGE(PG8_SA(1, 1), a1 + hstepA, voffA);
            PG8_WAIT_V(8); PG8_WAIT_L(0); PG8_BAR; PG8_MMA(0, 0, At, B0); PG8_MMA(0, 1, At, B1); PG8_BAR; PG8_SCHED;
            PG8_LDA(At, 0, 1); PG8_STAGE(PG8_SB(0, 0), b2, voffB); PG8_STAGE(PG8_SB(0, 1), b2 + hstepB, voffB); PG8_STAGE(PG8_SA(0, 0), a2, voffA);
            PG8_WAIT_V(8); PG8_WAIT_L(0); PG8_BAR; PG8_MMA(1, 0, At, B0); PG8_MMA(1, 1, At, B1); PG8_BAR; PG8_SCHED;
            PG8_LDB(B0, 1, 0); PG8_LDB(B1, 1, 1); PG8_SCHED; PG8_LDA(At, 1, 0); PG8_STAGE(PG8_SA(0, 1), a2 + hstepA, voffA);
            PG8_WAIT_V(8); PG8_WAIT_L(0); PG8_BAR; PG8_MMA(0, 0, At, B0); PG8_MMA(0, 1, At, B1); PG8_BAR; PG8_SCHED;
            PG8_LDA(At, 1, 1); PG8_STAGE(PG8_SB(1, 0), b3, voffB); PG8_STAGE(PG8_SB(1, 1), b3 + hstepB, voffB); PG8_STAGE(PG8_SA(1, 0), a3, voffA);
            PG8_WAIT_V(8); PG8_WAIT_L(0); PG8_BAR; PG8_MMA(1, 0, At, B0); PG8_MMA(1, 1, At, B1); PG8_BAR; PG8_SCHED;
            } else {
            PG8_LDB(B0, 0, 0); PG8_SCHED; PG8_LDA(At, 0, 0); PG8_STAGE(PG8_SA(1, 1), a1 + hstepA, voffA);
            PG8_WAIT_L(8); PG8_BAR; PG8_WAIT_L(0); PG8_MMA(0, 0, At, B0); PG8_BAR; PG8_SCHED;
            PG8_LDB(B1, 0, 1); PG8_STAGE(PG8_SB(0, 0), b2, voffB);
            PG8_BAR; PG8_WAIT_L(0); PG8_MMA(0, 1, At, B1); PG8_BAR;
            PG8_LDA(At, 0, 1); PG8_STAGE(PG8_SA(0, 0), a2, voffA);
            PG8_BAR; PG8_WAIT_L(0); PG8_MMA(1, 0, At, B0); PG8_BAR; PG8_SCHED;
            PG8_STAGE(PG8_SB(0, 1), b2 + hstepB, voffB);
            PG8_WAIT_V(6); PG8_BAR; PG8_MMA(1, 1, At, B1); PG8_BAR;
            PG8_LDB(B0, 1, 0); PG8_SCHED; PG8_LDA(At, 1, 0); PG8_STAGE(PG8_SA(0, 1), a2 + hstepA, voffA);
            PG8_WAIT_L(8); PG8_BAR; PG8_WAIT_L(0); PG8_MMA(0, 0, At, B0); PG8_BAR; PG8_SCHED;
            PG8_LDB(B1, 1, 1); PG8_STAGE(PG8_SB(1, 0), b3, voffB);
            PG8_BAR; PG8_WAIT_L(0); PG8_MMA(0, 1, At, B1); PG8_BAR;
            PG8_LDA(At, 1, 1); PG8_STAGE(PG8_SA(1, 0), a3, voffA);
            PG8_BAR; PG8_WAIT_L(0); PG8_MMA(1, 0, At, B0); PG8_BAR; PG8_SCHED;
            PG8_STAGE(PG8_SB(1, 1), b3 + hstepB, voffB);
            PG8_WAIT_V(6); PG8_BAR; PG8_MMA(1, 1, At, B1); PG8_BAR;
            }
        }
        if constexpr (ALIGN_EPI) { if (wr == 0) PG8_BAR; }
        if constexpr (!Epi::AFTER_DRAIN) { E(acc, cur, wr, wc, fr, fq); S.done(cur); }
        if (!has_next) break;
#pragma unroll
        for (int a = 0; a < 2; ++a)
#pragma unroll
            for (int b = 0; b < 2; ++b)
#pragma unroll
                for (int m = 0; m < 4; ++m)
#pragma unroll
                    for (int n = 0; n < 2; ++n) acc[a][b][m][n] = (f32x4){0.f, 0.f, 0.f, 0.f};
        cur = nxt; cA = nA; cB = nB; ++ui;
        if constexpr (ALIGN_EPI) { if (wr == 1) PG8_BAR; }
    }
    PG8_WAIT_V(0);
    if constexpr (!ALIGN_EPI) { if (wr == 0) PG8_BAR; }
    PG8_BAR;
    if constexpr (Epi::AFTER_DRAIN) { E.fused(acc, cur, wr, wc, fr, fq, lds, wid, lane); S.done(cur); }
#undef PG8_SA
#undef PG8_SB
#undef PG8_STAGE
#undef PG8_LDA
#undef PG8_LDB
#undef PG8_MMA
#undef PG8_WAIT_V
#undef PG8_WAIT_L
#undef PG8_BAR
#undef PG8_SCHED
}
}

namespace att {
constexpr int D = 128, NW = 8, QBLK = 32, KVBLK = 64, LDP = EVEN_IN;
constexpr float SCALE = 0.088388347648318440f, THR = 8.f;
constexpr size_t SHM_V = KVBLK * D * 2, SHM_K = KVBLK * D * 2, SHM_ATTN = 2 * SHM_V + 2 * SHM_K + NW * 64 * 4;
#define KSWZ(row, colB) ((row) * 256 + ((colB) ^ (((row) & 7) << 4)))
#define SBAR() __builtin_amdgcn_sched_barrier(0)
__device__ __forceinline__ int crow(int r, int hi) { return (r & 3) + 8 * (r >> 2) + 4 * hi; }

__device__ __forceinline__ void partialSM(f32x16& p0, f32x16& p1, float& m_reg, float& mn, float& alpha) {
  constexpr float C = SCALE * 1.4426950408889634f;
  float pmax = p0[0];
#pragma unroll
  for (int r = 1; r < 16; ++r) pmax = fmaxf(pmax, p0[r]);
#pragma unroll
  for (int r = 0; r < 16; ++r) pmax = fmaxf(pmax, p1[r]);
  { auto rr = __builtin_amdgcn_permlane32_swap(__float_as_uint(pmax), __float_as_uint(pmax), false, false);
    pmax = fmaxf(__uint_as_float(rr[0]), __uint_as_float(rr[1])); }
  if (__builtin_expect(__all(pmax - m_reg <= THR / SCALE), 1)) { mn = m_reg; alpha = 1.f; }
  else { mn = fmaxf(m_reg, pmax); alpha = __builtin_amdgcn_exp2f((m_reg - mn) * C); m_reg = mn; }
  float mnC = -mn * C;
#pragma unroll
  for (int r = 0; r < 16; ++r) p0[r] = fmaf(p0[r], C, mnC);
#pragma unroll
  for (int r = 0; r < 16; ++r) p1[r] = fmaf(p1[r], C, mnC);
#pragma unroll
  for (int r = 0; r < 16; ++r) p0[r] = __builtin_amdgcn_exp2f(p0[r]);
}
__device__ __forceinline__ void finishSM(f32x16& p0, f32x16& p1, float alpha, float& l_reg, bf16x8& pa0, bf16x8& pa1, bf16x8& pa2, bf16x8& pa3) {
#pragma unroll
  for (int r = 0; r < 16; ++r) p1[r] = __builtin_amdgcn_exp2f(p1[r]);
  float ps = 0;
#pragma unroll
  for (int r = 0; r < 16; ++r) ps += p0[r];
#pragma unroll
  for (int r = 0; r < 16; ++r) ps += p1[r];
  { auto rr = __builtin_amdgcn_permlane32_swap(__float_as_uint(ps), __float_as_uint(ps), false, false);
    ps = __uint_as_float(rr[0]) + __uint_as_float(rr[1]); }
  l_reg = l_reg * alpha + ps;
#define PK4(P, BASE, OUT) do { unsigned a0 = cvt_pk_bf16(P[BASE + 0], P[BASE + 1]), a1 = cvt_pk_bf16(P[BASE + 2], P[BASE + 3]);   \
    unsigned b0 = cvt_pk_bf16(P[BASE + 4], P[BASE + 5]), b1 = cvt_pk_bf16(P[BASE + 6], P[BASE + 7]);                              \
    auto r0 = __builtin_amdgcn_permlane32_swap(a0, b0, false, false); auto r1 = __builtin_amdgcn_permlane32_swap(a1, b1, false, false); \
    u32x4 w = {r0[0], r1[0], r0[1], r1[1]}; OUT = *reinterpret_cast<bf16x8*>(&w); } while (0)
  PK4(p0, 0, pa0); PK4(p0, 8, pa1); PK4(p1, 0, pa2); PK4(p1, 8, pa3);
#undef PK4
}
__device__ __forceinline__ void qkt(f32x16& p0, f32x16& p1, const bf16_t* Ks, const bf16x8* qr, int r32, int hi) {
  p0 = f32x16{}; p1 = f32x16{};
#pragma unroll
  for (int d0 = 0; d0 < 8; ++d0) { int cb = (d0 * 16 + hi * 8) * 2;
    bf16x8 b0 = *reinterpret_cast<const bf16x8*>((const char*)Ks + KSWZ(r32, cb));
    bf16x8 b1 = *reinterpret_cast<const bf16x8*>((const char*)Ks + KSWZ(32 + r32, cb));
    p0 = __builtin_amdgcn_mfma_f32_32x32x16_bf16(b0, qr[d0], p0, 0, 0, 0);
    p1 = __builtin_amdgcn_mfma_f32_32x32x16_bf16(b1, qr[d0], p1, 0, 0, 0); }
}
__device__ __forceinline__ int v_st(int k, int c) { const int kk = (k & ~0xC) | ((k & 4) << 1) | ((k & 8) >> 1); return ((kk >> 3) * 4 + (c >> 5)) * 512 + ((kk & 7) * 32 + (c & 31)) * 2; }
__device__ __forceinline__ int v_rd_base(int lane) { return ((lane & 3) << 3) | (((lane >> 2) & 3) << 6) | (((lane >> 4) & 1) << 5) | (((lane >> 5) & 1) << 8); }
constexpr int v_rd_off(int d0, int ks, int half) { return d0 * 512 + ks * 4096 + half * 2048; }
template <int OFF> __device__ __forceinline__ s16x4 tr_read(int vb) {
  s16x4 r; asm volatile("ds_read_b64_tr_b16 %0, %1 offset:%2" : "=&v"(r) : "v"(vb), "i"(OFF) : "memory"); return r;
}
template <int D0> __device__ __forceinline__ void pv_one(f32x16& od, int vb, bf16x8 pa0, bf16x8 pa1, bf16x8 pa2, bf16x8 pa3) {
  const s16x4 l0 = tr_read<v_rd_off(D0, 0, 0)>(vb), h0 = tr_read<v_rd_off(D0, 0, 1)>(vb), l1 = tr_read<v_rd_off(D0, 1, 0)>(vb), h1 = tr_read<v_rd_off(D0, 1, 1)>(vb);
  const s16x4 l2 = tr_read<v_rd_off(D0, 2, 0)>(vb), h2 = tr_read<v_rd_off(D0, 2, 1)>(vb), l3 = tr_read<v_rd_off(D0, 3, 0)>(vb), h3 = tr_read<v_rd_off(D0, 3, 1)>(vb);
  asm volatile("s_waitcnt lgkmcnt(0)" ::: "memory"); SBAR();
#define PK(L, H) (bf16x8){L[0], L[1], L[2], L[3], H[0], H[1], H[2], H[3]}
  od = __builtin_amdgcn_mfma_f32_32x32x16_bf16(pa0, PK(l0, h0), od, 0, 0, 0);
  od = __builtin_amdgcn_mfma_f32_32x32x16_bf16(pa1, PK(l1, h1), od, 0, 0, 0);
  od = __builtin_amdgcn_mfma_f32_32x32x16_bf16(pa2, PK(l2, h2), od, 0, 0, 0);
  od = __builtin_amdgcn_mfma_f32_32x32x16_bf16(pa3, PK(l3, h3), od, 0, 0, 0);
#undef PK
}
__device__ __forceinline__ void pv_d0(f32x16* o, int vb, bf16x8 pa0, bf16x8 pa1, bf16x8 pa2, bf16x8 pa3) {
  pv_one<0>(o[0], vb, pa0, pa1, pa2, pa3); pv_one<1>(o[1], vb, pa0, pa1, pa2, pa3); pv_one<2>(o[2], vb, pa0, pa1, pa2, pa3); pv_one<3>(o[3], vb, pa0, pa1, pa2, pa3);
}

template <bool WIN>
__device__ __forceinline__ void attn_unit(const bf16_t* __restrict__ Qb, const bf16_t* __restrict__ Kc, const bf16_t* __restrict__ Vc, const bf16_t* __restrict__ Zb,
                                          bf16_t* __restrict__ Yb, long lat0, long ctx0, int q0, float sinkv, const float* __restrict__ qn, const float* __restrict__ rowtab, const float* __restrict__ coltab, char* lds) {
  const int tid = threadIdx.x, wid = tid >> 6, lane = tid & 63, r32 = lane & 31, hi = lane >> 5;
  bf16_t* V_lds = (bf16_t*)lds; bf16_t* K_lds = (bf16_t*)(lds + 2 * SHM_V);
  float* ws = (float*)(lds + 2 * SHM_V + 2 * SHM_K) + wid * 64; float* li_l = ws; float* al_l = ws + 32;
  float m_reg = -1e30f, l_reg = 0; f32x16 o[4] = {}; bf16x8 qr[8];
  const bf16_t* Qw = Qb + (long)(wid * QBLK + r32) * LDP + hi * 8;
  {
    u32x4 qw[8];
#pragma unroll
    for (int d0 = 0; d0 < 8; ++d0) qw[d0] = *reinterpret_cast<const u32x4*>(Qw + d0 * 16);
    float rstd = 1.f;
    if (!WIN) {
      float ss = 0.f;
#pragma unroll
      for (int d0 = 0; d0 < 8; ++d0) { const float a0 = bf_lo(qw[d0].x), a1 = bf_hi(qw[d0].x), a2 = bf_lo(qw[d0].y), a3 = bf_hi(qw[d0].y), a4 = bf_lo(qw[d0].z), a5 = bf_hi(qw[d0].z), a6 = bf_lo(qw[d0].w), a7 = bf_hi(qw[d0].w);
        ss += (a0 * a0 + a1 * a1) + (a2 * a2 + a3 * a3) + (a4 * a4 + a5 * a5) + (a6 * a6 + a7 * a7); }
      ss += __shfl_xor(ss, 32);
      rstd = 1.0f / sqrtf(ss * (1.f / D) + EPS);
    }
    const int tq = q0 + wid * QBLK + r32, prow = tq >> 6, pcol = tq & 63;
#pragma unroll
    for (int d0 = 0; d0 < 4; ++d0) {
      float x1[8] = {bf_lo(qw[d0].x), bf_hi(qw[d0].x), bf_lo(qw[d0].y), bf_hi(qw[d0].y), bf_lo(qw[d0].z), bf_hi(qw[d0].z), bf_lo(qw[d0].w), bf_hi(qw[d0].w)};
      float x2[8] = {bf_lo(qw[d0 + 4].x), bf_hi(qw[d0 + 4].x), bf_lo(qw[d0 + 4].y), bf_hi(qw[d0 + 4].y), bf_lo(qw[d0 + 4].z), bf_hi(qw[d0 + 4].z), bf_lo(qw[d0 + 4].w), bf_hi(qw[d0 + 4].w)};
      if (!WIN) {
        const float* g1p = qn + d0 * 16 + hi * 8; const f32x4 ga = *(const f32x4*)g1p, gb = *(const f32x4*)(g1p + 4), gc = *(const f32x4*)(g1p + 64), gd = *(const f32x4*)(g1p + 68);
#pragma unroll
        for (int e = 0; e < 4; ++e) { x1[e] *= rstd * ga[e]; x1[4 + e] *= rstd * gb[e]; x2[e] *= rstd * gc[e]; x2[4 + e] *= rstd * gd[e]; }
      }
      const float* tab = (d0 < 2) ? (rowtab + (prow * 32 + d0 * 16 + hi * 8) * 2) : (coltab + (pcol * 32 + (d0 - 2) * 16 + hi * 8) * 2);
      f32x4 tb[4];
#pragma unroll
      for (int q = 0; q < 4; ++q) tb[q] = *(const f32x4*)(tab + 4 * q);
      float r1[8], r2[8];
#pragma unroll
      for (int e = 0; e < 8; ++e) { const float cs = tb[e >> 1][(e & 1) * 2], sn = tb[e >> 1][(e & 1) * 2 + 1];
        r1[e] = x1[e] * cs - x2[e] * sn; r2[e] = x2[e] * cs + x1[e] * sn; }
      u32x4 w1 = {cvt_pk_bf16(r1[0], r1[1]), cvt_pk_bf16(r1[2], r1[3]), cvt_pk_bf16(r1[4], r1[5]), cvt_pk_bf16(r1[6], r1[7])};
      u32x4 w2 = {cvt_pk_bf16(r2[0], r2[1]), cvt_pk_bf16(r2[2], r2[3]), cvt_pk_bf16(r2[4], r2[5]), cvt_pk_bf16(r2[6], r2[7])};
      qr[d0] = *reinterpret_cast<bf16x8*>(&w1); qr[d0 + 4] = *reinterpret_cast<bf16x8*>(&w2);
    }
  }
  const int sr = tid >> 4, sc = (tid & 15) * 8, vst0 = v_st(sr, sc), vst1 = v_st(32 + sr, sc);
  const int vb0 = (int)(uintptr_t)V_lds + v_rd_base(lane);
  const int tb0 = WIN ? ((q0 / 64 - 2) > 0 ? (q0 / 64 - 2) : 0) : 0;
  const int tb1 = WIN ? ((q0 / 64 + 5) < 255 ? (q0 / 64 + 5) : 255) : 0;
  const int NT = WIN ? (4 + tb1 - tb0 + 1) : (SEQ / KVBLK + CTX / KVBLK);
#define TROW(t) (WIN ? ((t) < 4 ? ctx0 + 64 * (t) : lat0 + 64 * (long)(tb0 + (t) - 4)) : ((t) < SEQ / KVBLK ? lat0 + 64 * (long)(t) : ctx0 + 64 * (long)((t) - SEQ / KVBLK)))
  struct { bf16x8 vs0, vs1, ks0, ks1; } sr_[2];
  const int ldo0 = sr * LDP + sc, ldo1 = (32 + sr) * LDP + sc;
#define SLOAD(i, t) do { const long R_ = TROW(t); const bf16_t* vt_ = Vc + R_ * LDP; const bf16_t* kt_ = Kc + R_ * LDP; \
    sr_[i].vs0 = *reinterpret_cast<const bf16x8*>(vt_ + ldo0); sr_[i].vs1 = *reinterpret_cast<const bf16x8*>(vt_ + ldo1); \
    sr_[i].ks0 = *reinterpret_cast<const bf16x8*>(kt_ + ldo0); sr_[i].ks1 = *reinterpret_cast<const bf16x8*>(kt_ + ldo1); } while (0)
#define SWRITE(b, i) do { *(bf16x8*)((char*)V_lds + (b) * SHM_V + vst0) = sr_[i].vs0;          \
    *(bf16x8*)((char*)V_lds + (b) * SHM_V + vst1) = sr_[i].vs1; int kc = sc * 2;               \
    *(bf16x8*)((char*)K_lds + (b) * SHM_K + KSWZ(sr, kc)) = sr_[i].ks0;                       \
    *(bf16x8*)((char*)K_lds + (b) * SHM_K + KSWZ(32 + sr, kc)) = sr_[i].ks1; } while (0)
#define SWAIT() asm volatile("s_waitcnt vmcnt(4)" ::: "memory")
#define RESC(a) do { if (__any((a) < 1.f)) { if (hi == 0) al_l[r32] = (a); asm volatile("s_waitcnt lgkmcnt(0)" ::: "memory"); \
    _Pragma("unroll") for (int d = 0; d < 4; ++d) _Pragma("unroll") for (int r = 0; r < 16; ++r) o[d][r] *= al_l[crow(r, hi)]; } } while (0)
#define MASKT(P0, P1, t) do { if (WIN && (t) >= 4) { const int dk_ = 64 * (tb0 + (t) - 4) - (q0 + wid * QBLK + r32); \
    _Pragma("unroll") for (int r = 0; r < 16; ++r) { const int d_ = dk_ + crow(r, hi); \
      if (d_ > 128 || d_ < -128) P0[r] = -1e30f; if (d_ + 32 > 128 || d_ + 32 < -128) P1[r] = -1e30f; } } } while (0)
  f32x16 pA0, pA1, pB0, pB1; float mnA, mnB, alA, alB; bf16x8 pa0, pa1, pa2, pa3;
  constexpr int SE = 0, SO = 1;
  SLOAD(SE, 0); asm volatile("s_waitcnt vmcnt(0)" ::: "memory"); SWRITE(0, SE); __syncthreads();
  qkt(pA0, pA1, K_lds, qr, r32, hi); MASKT(pA0, pA1, 0); partialSM(pA0, pA1, m_reg, mnA, alA);
  SLOAD(SO, 1); if (2 < NT) SLOAD(SE, 2);
  SWAIT(); SWRITE(1, SO); __syncthreads();
  for (int j = 1; j + 1 < NT; j += 2) {
    SBAR(); qkt(pB0, pB1, (bf16_t*)((char*)K_lds + SHM_K), qr, r32, hi);
    finishSM(pA0, pA1, alA, l_reg, pa0, pa1, pa2, pa3); SBAR();
    SLOAD(SO, j + 2); SBAR();
    pv_d0(o, vb0, pa0, pa1, pa2, pa3); MASKT(pB0, pB1, j); partialSM(pB0, pB1, m_reg, mnB, alB);
    __syncthreads(); SWAIT(); SWRITE(0, SE);
    RESC(alB); __syncthreads();
    SBAR(); qkt(pA0, pA1, K_lds, qr, r32, hi);
    finishSM(pB0, pB1, alB, l_reg, pa0, pa1, pa2, pa3); SBAR();
    if (j + 3 < NT) SLOAD(SE, j + 3); SBAR();
    pv_d0(o, vb0 + (int)SHM_V, pa0, pa1, pa2, pa3); MASKT(pA0, pA1, j + 1); partialSM(pA0, pA1, m_reg, mnA, alA);
    __syncthreads(); SWAIT(); SWRITE(1, SO);
    RESC(alA); __syncthreads();
  }
  SBAR(); qkt(pB0, pB1, (bf16_t*)((char*)K_lds + SHM_K), qr, r32, hi);
  finishSM(pA0, pA1, alA, l_reg, pa0, pa1, pa2, pa3); SBAR();
  pv_d0(o, vb0, pa0, pa1, pa2, pa3); MASKT(pB0, pB1, NT - 1); partialSM(pB0, pB1, m_reg, mnB, alB);
  __syncthreads(); RESC(alB);
  finishSM(pB0, pB1, alB, l_reg, pa0, pa1, pa2, pa3); SBAR();
  pv_d0(o, vb0 + (int)SHM_V, pa0, pa1, pa2, pa3);
  if (WIN) l_reg += __builtin_amdgcn_exp2f(sinkv * 1.4426950408889634f - m_reg * (SCALE * 1.4426950408889634f));
  if (hi == 0) li_l[r32] = l_reg; asm volatile("s_waitcnt lgkmcnt(0)" ::: "memory");
  float rli[16];
#pragma unroll
  for (int r = 0; r < 16; ++r) rli[r] = __builtin_amdgcn_rcpf(li_l[4 * hi + (r & 3) + 8 * (r >> 2)]);
  __syncthreads();
  { bf16_t* stg = (bf16_t*)lds + wid * (QBLK * D); bf16_t* sp = stg + (4 * hi) * D + r32;
#pragma unroll
    for (int r = 0; r < 16; ++r) {
#pragma unroll
      for (int d0 = 0; d0 < 4; ++d0) { const float y = o[d0][r] * rli[r]; sp[((r & 3) + 8 * (r >> 2)) * D + d0 * 32] = (bf16_t)(cvt_pk_bf16(y, y) & 0xffffu); } }
    asm volatile("s_waitcnt lgkmcnt(0)" ::: "memory");
    const int row0 = lane >> 4, ch = (lane & 15) * 8;
    const bf16_t* Zw = Zb + (long)(wid * QBLK + row0) * LDP + ch; bf16_t* Yw = Yb + (long)(wid * QBLK + row0) * DM + ch; const bf16_t* sq = stg + row0 * D + ch;
#pragma unroll
    for (int i = 0; i < 8; ++i) {
      const u32x4 v = *(const u32x4*)(sq + i * 4 * D); const u32x4 z = *(const u32x4*)(Zw + (long)i * 4 * LDP);
      u32x4 w; w.x = cvt_pk_bf16(bf_lo(v.x) * bf_lo(z.x), bf_hi(v.x) * bf_hi(z.x)); w.y = cvt_pk_bf16(bf_lo(v.y) * bf_lo(z.y), bf_hi(v.y) * bf_hi(z.y));
      w.z = cvt_pk_bf16(bf_lo(v.z) * bf_lo(z.z), bf_hi(v.z) * bf_hi(z.z)); w.w = cvt_pk_bf16(bf_lo(v.w) * bf_lo(z.w), bf_hi(v.w) * bf_hi(z.w));
      *(u32x4*)(Yw + (long)i * 4 * DM) = w; } }
  __syncthreads();
#undef TROW
#undef SLOAD
#undef SWRITE
#undef SWAIT
#undef RESC
#undef MASKT
}
}

constexpr size_t MiB = 1u << 20;
constexpr size_t WS_MODP = 0;
constexpr size_t WS_MOD = 8 * MiB;
constexpr size_t WS_ROPE = 9 * MiB;
constexpr size_t WS_BAR = 9 * MiB + 512 * 1024;
constexpr size_t WS_W0IN = 10 * MiB;
constexpr size_t WS_W0OUT = 30 * MiB;
constexpr size_t WS_W1IN = 38 * MiB;
constexpr size_t WS_WPOOL = 54 * MiB;
constexpr size_t WS_W1OUT = 56 * MiB;
constexpr size_t WS_H = 64 * MiB;
constexpr size_t WS_P = 196 * MiB;
constexpr size_t WS_Y = 524 * MiB;
constexpr size_t WS_T = 652 * MiB;
constexpr size_t WS_END = 780 * MiB;
constexpr int LDS_BYTES = 147456, MISC_OFF = 131072 + 320;
#ifndef ATT_SEL
#define ATT_SEL 3
#endif

#define XB_TMO      128
#define XB_XCNT(j)  (256  + 64 * (j))
#define XB_XSUB(j)  (1280 + 64 * (j))
#define XB_XGEN(j)  (2304 + 64 * (j))
#define XB_TOP      3328
#define XB_TOPGEN   3392
#define XCD_BAR_WORDS 3456
#define XB_SPIN_CAP (1u << 18)

__device__ __forceinline__ unsigned xb_ld(unsigned* p)              { return __hip_atomic_load(p, __ATOMIC_RELAXED, __HIP_MEMORY_SCOPE_AGENT); }
__device__ __forceinline__ unsigned xb_add(unsigned* p, unsigned v) { return __hip_atomic_fetch_add(p, v, __ATOMIC_RELAXED, __HIP_MEMORY_SCOPE_AGENT); }
__device__ __forceinline__ unsigned xb_xcc_id() { return (unsigned)__builtin_amdgcn_s_getreg((3 << 11) | 20) & 0xFu; }
#define XB_SPIN(cond, bar) do { unsigned _sp = 0; while (cond) { __builtin_amdgcn_s_sleep(1); \
    if ((++_sp & 255u) == 0u) { if (xb_ld(&(bar)[XB_TMO])) break; if (_sp > XB_SPIN_CAP) { atomicAdd(&(bar)[XB_TMO], 1u); break; } } } } while (0)

struct XcdBarrier {
    unsigned* bar; unsigned x;
    volatile LAS unsigned* st;
};

__device__ __forceinline__ XcdBarrier xcd_barrier_post(unsigned* bar, volatile LAS unsigned* st) {
    XcdBarrier b; b.bar = bar; b.x = xb_xcc_id(); b.st = st;
    if (threadIdx.x == 0) (void)xb_add(&bar[XB_XCNT(b.x)], 1u);
    return b;
}
__device__ __forceinline__ void xcd_barrier_complete(unsigned* bar, unsigned x, unsigned& nloc, unsigned& nx) {
    const unsigned G = gridDim.x * gridDim.y * gridDim.z;
    unsigned sum, cnt, mine, sp = 0u;
    for (;;) {
        sum = 0u; cnt = 0u; mine = 0u;
#pragma unroll
        for (unsigned j = 0; j < 16; ++j) { const unsigned c = xb_ld(&bar[XB_XCNT(j)]); sum += c; cnt += (c > 0u) ? 1u : 0u; mine = (j == x) ? c : mine; }
        if (sum == G) break;
        __builtin_amdgcn_s_sleep(1);
        if ((++sp & 255u) == 0u) { if (xb_ld(&bar[XB_TMO])) break; if (sp > XB_SPIN_CAP) { atomicAdd(&bar[XB_TMO], 1u); break; } }
    }
    nloc = mine > 0u ? mine : 1u; nx = cnt > 0u ? cnt : 1u;
}

__device__ __forceinline__ void xcd_barrier(const XcdBarrier& b) {
    asm volatile("s_waitcnt vmcnt(0)" ::: "memory");
    __syncthreads();
    if (threadIdx.x == 0) {
        unsigned* bar = b.bar;
        __builtin_amdgcn_s_waitcnt(0);
        unsigned nloc = b.st[0], nx = b.st[1];
        if (nloc == 0u) { xcd_barrier_complete(bar, b.x, nloc, nx); b.st[0] = nloc; b.st[1] = nx; }
        const unsigned old = xb_add(&bar[XB_XSUB(b.x)], 1u);
        const unsigned gen = old / nloc;
        if (old + 1u == (gen + 1u) * nloc) {
            __builtin_amdgcn_fence(__ATOMIC_RELEASE, "agent");
            asm volatile("s_waitcnt vmcnt(0)" ::: "memory");
            const unsigned og = xb_add(&bar[XB_TOP], 1u);
            const unsigned tg = og / nx;
            if (og + 1u == (tg + 1u) * nx) xb_add(&bar[XB_TOPGEN], 1u);
            else XB_SPIN(xb_ld(&bar[XB_TOPGEN]) == tg, bar);
            __builtin_amdgcn_fence(__ATOMIC_ACQUIRE, "agent");
            xb_add(&bar[XB_XGEN(b.x)], 1u);
            asm volatile("s_waitcnt vmcnt(0)" ::: "memory");
        } else {
            XB_SPIN(xb_ld(&bar[XB_XGEN(b.x)]) == gen, bar);
            __builtin_amdgcn_fence(__ATOMIC_ACQUIRE, "agent");
            asm volatile("s_waitcnt vmcnt(0)" ::: "memory");
        }
    }
    __syncthreads();
}

struct Args { const float* in[21]; float* out; unsigned char* ws; double cs1[32], sn1[32]; int ph_lo, ph_hi; };

__device__ __forceinline__ float wave_sum(float v) {
#pragma unroll
    for (int o = 1; o < 64; o <<= 1) v += __shfl_xor(v, o);
    return v;
}
__device__ __forceinline__ unsigned f2bf(float f) { unsigned u = __builtin_bit_cast(unsigned, f); return (u + 0x7fffu + ((u >> 16) & 1u)) >> 16; }
__device__ __forceinline__ unsigned pk2(float lo, float hi) { return f2bf(lo) | (f2bf(hi) << 16); }

__device__ __forceinline__ void transpose_item(const float* W, int K, int N, bf16_t* WT, int row_off, LAS float* scr, int item, int lane) {
    const int nblk = N / 32, kb = item / nblk, nb = item % nblk, k0 = 64 * kb, n0 = 32 * nb;
#pragma unroll 8
    for (int i = 0; i < 32; ++i) { const int kk = 2 * i + (lane >> 5); scr[kk * 33 + (lane & 31)] = W[(size_t)(k0 + kk) * N + n0 + (lane & 31)]; }
    asm volatile("s_waitcnt lgkmcnt(0)" ::: "memory");
    const int c = lane & 7;
#pragma unroll
    for (int j = 0; j < 4; ++j) { const int n = (lane >> 3) + 8 * j; const LAS float* s = scr + (8 * c) * 33 + n;
        u32x4 o; o.x = pk2(s[0 * 33], s[1 * 33]); o.y = pk2(s[2 * 33], s[3 * 33]); o.z = pk2(s[4 * 33], s[5 * 33]); o.w = pk2(s[6 * 33], s[7 * 33]);
        *(u32x4*)(WT + (size_t)(row_off + n0 + n) * K + k0 + 8 * c) = o; }
    asm volatile("s_waitcnt lgkmcnt(0)" ::: "memory");
}

__device__ __forceinline__ void prenorm_row(const float* xrow, const float* g, const float* shift, const float* scale, bf16_t* orow, int lane) {
    f32x4 v[8]; float s = 0.f;
#pragma unroll
    for (int j = 0; j < 8; ++j) { v[j] = *(const f32x4*)(xrow + 4 * lane + 256 * j); s += (v[j].x * v[j].x + v[j].y * v[j].y) + (v[j].z * v[j].z + v[j].w * v[j].w); }
    const float rstd = 1.0f / sqrtf(wave_sum(s) * (1.f / DM) + EPS);
#pragma unroll
    for (int j = 0; j < 8; ++j) { const int c = 4 * lane + 256 * j; const f32x4 gg = *(const f32x4*)(g + c), sh = *(const f32x4*)(shift + c), sc = *(const f32x4*)(scale + c);
        const f32x4 y = v[j] * rstd * gg * (sc + 1.0f) + sh;
        u32x2 w; w.x = cvt_pk_bf16(y.x, y.y); w.y = cvt_pk_bf16(y.z, y.w); *(u32x2*)(orow + c) = w; }
}
template <bool NEXT>
__device__ __forceinline__ void postnorm_row(const bf16_t* trow, const float* xres, const float* post_g, const float* gate, float* xout,
                                             const float* g2, const float* shift2, const float* scale2, bf16_t* hrow, int lane) {
    f32x4 t[8]; float s = 0.f;
#pragma unroll
    for (int j = 0; j < 8; ++j) { const u32x2 w = *(const u32x2*)(trow + 4 * lane + 256 * j); t[j] = (f32x4){bf_lo(w.x), bf_hi(w.x), bf_lo(w.y), bf_hi(w.y)};
        s += (t[j].x * t[j].x + t[j].y * t[j].y) + (t[j].z * t[j].z + t[j].w * t[j].w); }
    const float rstd = 1.0f / sqrtf(wave_sum(s) * (1.f / DM) + EPS);
    float s2 = 0.f;
#pragma unroll
    for (int j = 0; j < 8; ++j) { const int c = 4 * lane + 256 * j; const f32x4 pg = *(const f32x4*)(post_g + c), ga = *(const f32x4*)(gate + c), xr = *(const f32x4*)(xres + c);
        t[j] = xr + ga * (t[j] * rstd * pg); *(f32x4*)(xout + c) = t[j];
        s2 += (t[j].x * t[j].x + t[j].y * t[j].y) + (t[j].z * t[j].z + t[j].w * t[j].w); }
    if (NEXT) {
        const float rstd2 = 1.0f / sqrtf(wave_sum(s2) * (1.f / DM) + EPS);
#pragma unroll
        for (int j = 0; j < 8; ++j) { const int c = 4 * lane + 256 * j; const f32x4 gg = *(const f32x4*)(g2 + c), sh = *(const f32x4*)(shift2 + c), sc = *(const f32x4*)(scale2 + c);
            const f32x4 y = t[j] * rstd2 * gg * (sc + 1.0f) + sh;
            u32x2 w; w.x = cvt_pk_bf16(y.x, y.y); w.y = cvt_pk_bf16(y.z, y.w); *(u32x2*)(hrow + c) = w; }
    }
}

template <int H>
__device__ __forceinline__ void pool_chunk(const bf16_t* __restrict__ Pp, bf16_t* __restrict__ Hp, size_t base, int t0, int cg8) {
    constexpr int NR = 8 + 2 * H - 1;
    u32x4 w[NR];
#pragma unroll
    for (int i = 0; i < NR; ++i) { const int t = t0 - H + i; w[i] = (u32x4){0u, 0u, 0u, 0u}; if (t >= 0 && t < SEQ) w[i] = *(const u32x4*)(Pp + (base + t) * ODD_IN + cg8); }
    float S[8] = {0.f, 0.f, 0.f, 0.f, 0.f, 0.f, 0.f, 0.f};
#pragma unroll
    for (int i = 0; i < 2 * H; ++i) { S[0] += bf_lo(w[i].x); S[1] += bf_hi(w[i].x); S[2] += bf_lo(w[i].y); S[3] += bf_hi(w[i].y); S[4] += bf_lo(w[i].z); S[5] += bf_hi(w[i].z); S[6] += bf_lo(w[i].w); S[7] += bf_hi(w[i].w); }
#pragma unroll
    for (int r = 0; r < 8; ++r) { const int t = t0 + r; const int tlo = (t - H) > 0 ? (t - H) : 0, thi = (t + H) < SEQ ? (t + H) : SEQ; const float inv = 1.0f / (float)(thi - tlo);
        const u32x4 ow = w[r + H];
        u32x4 o; o.x = cvt_pk_bf16(S[0] * inv - bf_lo(ow.x), S[1] * inv - bf_hi(ow.x)); o.y = cvt_pk_bf16(S[2] * inv - bf_lo(ow.y), S[3] * inv - bf_hi(ow.y));
        o.z = cvt_pk_bf16(S[4] * inv - bf_lo(ow.z), S[5] * inv - bf_hi(ow.z)); o.w = cvt_pk_bf16(S[6] * inv - bf_lo(ow.w), S[7] * inv - bf_hi(ow.w));
        *(u32x4*)(Hp + (base + t) * DM + cg8) = o;
        if (r < 7) { const u32x4 a = w[r + 2 * H], d = w[r];
            S[0] += bf_lo(a.x) - bf_lo(d.x); S[1] += bf_hi(a.x) - bf_hi(d.x); S[2] += bf_lo(a.y) - bf_lo(d.y); S[3] += bf_hi(a.y) - bf_hi(d.y);
            S[4] += bf_lo(a.z) - bf_lo(d.z); S[5] += bf_hi(a.z) - bf_hi(d.z); S[6] += bf_lo(a.w) - bf_lo(d.w); S[7] += bf_hi(a.w) - bf_hi(d.w); } }
}

__global__ void __launch_bounds__(512, 2) mk_fwd(Args args) {
    extern __shared__ __attribute__((aligned(16))) unsigned char lds[];
    cg::grid_group grid = cg::this_grid();
    const int wave = __builtin_amdgcn_readfirstlane(threadIdx.x >> 6);
#define LANE_TID const int lane = (int)__builtin_amdgcn_mbcnt_hi(~0u, __builtin_amdgcn_mbcnt_lo(~0u, 0u)); const int tid = wave * 64 + lane; (void)tid; (void)lane;
    const int G = gridDim.x, bx = blockIdx.x;
    const int vcu = (G % 8 == 0) ? (bx % 8) * (G / 8) + bx / 8 : bx;
    const int gw = vcu * 8 + wave, NGW = G * 8;
#define XIN (args.in[0])
#define cvec (args.in[1])
#define ctx (args.in[2])
#define c_ctx (args.in[3])
#define modp ((float*)(wsl + WS_MODP))
#define mod ((float*)(wsl + WS_MOD))
#define rowtab ((float*)(wsl + WS_ROPE))
#define coltab (rowtab + 256 * 32 * 2)
#define W0in ((bf16_t*)(wsl + WS_W0IN))
#define W0out ((bf16_t*)(wsl + WS_W0OUT))
#define W1in ((bf16_t*)(wsl + WS_W1IN))
#define Wpool ((bf16_t*)(wsl + WS_WPOOL))
#define W1out ((bf16_t*)(wsl + WS_W1OUT))
#define Hb ((bf16_t*)(wsl + WS_H))
#define Pb ((bf16_t*)(wsl + WS_P))
#define Yb ((bf16_t*)(wsl + WS_Y))
#define Tb ((bf16_t*)(wsl + WS_T))
#define PHASE_PTRS unsigned char* wsl = args.ws; asm volatile("" : "+s"(wsl)); LANE_TID
#define out (args.out)
    const int lo = args.ph_lo, hi = args.ph_hi;
    volatile LAS unsigned* MISC = (volatile LAS unsigned*)((LAS unsigned char*)lds + MISC_OFF);
    if (threadIdx.x < 32) MISC[threadIdx.x] = 0u;
    __syncthreads();
    if (lo < 0) { __threadfence(); grid.sync(); __threadfence(); }
    XcdBarrier bar = xcd_barrier_post((unsigned*)(args.ws + WS_BAR), MISC + 8);
#ifndef MK_MASK
#define MK_MASK 0x1fff
#endif
#define IN(k) (((MK_MASK >> (k)) & 1) && lo <= (k) && (k) < hi)
#ifndef MK_DUP
#define MK_DUP 0
#endif
#define REP(k) for (int rep_ = 0; rep_ < (((MK_DUP >> (k)) & 1) ? 2 : 1); ++rep_)
#define SEAM(k) do { if (IN(k) && IN((k) + 1)) xcd_barrier(bar); } while (0)

    if (IN(0)) REP(0) { PHASE_PTRS
        {
            LAS float* sl = (LAS float*)lds;
            for (int i = tid; i < 3 * DM; i += 512) { const float v = i < 2 * DM ? cvec[i] : c_ctx[i - 2 * DM]; sl[i] = silu_f(v); }
            __syncthreads();
            for (int it = bx; it < 2 * 12 * 32; it += G) {
                const int l = it / 384, cb = (it % 384) / 32, kc = it % 32; const float* W = args.in[l ? 13 : 4]; const int j = cb * 512 + tid;
                float s0 = 0.f, s1 = 0.f, s2 = 0.f;
#pragma unroll 8
                for (int k = kc * 64; k < kc * 64 + 64; ++k) { const float w = W[(size_t)k * (3 * DM) + j]; s0 += sl[k] * w; s1 += sl[DM + k] * w; s2 += sl[2 * DM + k] * w; }
                float* pp = modp + ((size_t)(l * 32 + kc) * 3) * (3 * DM) + j; pp[0] = s0; pp[3 * DM] = s1; pp[2 * 3 * DM] = s2;
            }
            __syncthreads();
        }
        {
            LAS float* scr = (LAS float*)(lds + wave * 16384);
            constexpr int I0 = (DM / 64) * (EVEN_IN / 32), I1 = (DM / 64) * (DM / 32), I2 = (DM / 64) * (ODD_IN / 32), I3 = 4 * (512 / 64) * (512 / 32), I4 = I1;
            for (int it = gw; it < I0 + I1 + I2 + I3 + I4; it += NGW) {
                int r = it;
                if (r < I0) { transpose_item(args.in[8], DM, EVEN_IN, W0in, 0, scr, r, lane); continue; } r -= I0;
                if (r < I1) { transpose_item(args.in[12], DM, DM, W0out, 0, scr, r, lane); continue; } r -= I1;
                if (r < I2) { transpose_item(args.in[17], DM, ODD_IN, W1in, 0, scr, r, lane); continue; } r -= I2;
                if (r < I3) { const int g = r / 128; transpose_item(args.in[18] + (size_t)g * 512 * 512, 512, 512, Wpool, g * 512, scr, r % 128, lane); continue; } r -= I3;
                transpose_item(args.in[20], DM, DM, W1out, 0, scr, r, lane);
            }
        }
        if (bx == 0 && tid < 32) {
            const double c1 = args.cs1[tid], s1 = args.sn1[tid]; double c = 1.0, s = 0.0;
            for (int n = 0; n < 256; ++n) { rowtab[(n * 32 + tid) * 2] = (float)c; rowtab[(n * 32 + tid) * 2 + 1] = (float)s;
                if (n < 64) { coltab[(n * 32 + tid) * 2] = (float)c; coltab[(n * 32 + tid) * 2 + 1] = (float)s; }
                const double cn = c * c1 - s * s1, sn = s * c1 + c * s1; c = cn; s = sn; }
        }
    }
    SEAM(0);
    if (IN(1)) { PHASE_PTRS
        for (int i = bx * 512 + tid; i < 2 * 3 * 3 * DM; i += G * 512) {
            const int l = i / (9 * DM), v = (i / (3 * DM)) % 3, j = i % (3 * DM); float s = args.in[l ? 14 : 5][j];
            for (int kc = 0; kc < 32; ++kc) s += modp[((size_t)(l * 32 + kc) * 3 + v) * (3 * DM) + j];
            mod[i] = s;
        }
    }
    SEAM(1);
    if (IN(2)) REP(2) { PHASE_PTRS
        for (int m = gw; m < MALL; m += NGW) {
            const float* xr; int v;
            if (m < MLAT) { xr = XIN + (size_t)m * DM; v = m / SEQ; } else { xr = ctx + (size_t)(m - MLAT) * DM; v = 2; }
            const float* mv = mod + (size_t)v * 3 * DM;
            prenorm_row(xr, args.in[6], mv, mv + DM, Hb + (size_t)m * DM, lane);
        }
    }
    SEAM(2);
    if (IN(3)) REP(3) { PHASE_PTRS
        pg8::Gemm g{Hb, W0in, MALL, EVEN_IN, DM, DM, DM, 1 << 20}; pg8::StaticOrder S; S.init(MALL, EVEN_IN, G, bx);
        pg8::EpiMk E{Pb, EVEN_IN, COL_Z, nullptr, nullptr, 0};
        pg8::gemm_phase<pg8::EpiMk, pg8::StaticOrder, true, true>((LAS unsigned char*)lds, g, S, E);
    }
    SEAM(3);
    if (IN(4)) { PHASE_PTRS
        const float* qn = args.in[9]; const float* kn = args.in[10];
        const int sub = lane & 15, e0 = sub * 8, i0 = (sub & 7) * 8, hq = lane >> 4; const bool upper = sub >= 8;
        float gq[8], gk[8];
#pragma unroll
        for (int e = 0; e < 8; ++e) { gq[e] = qn[e0 + e]; gk[e] = kn[e0 + e]; }
        for (int m = gw; m < MALL; m += NGW) {
            const bool isctx = m >= MLAT;
            bf16_t* prow_ = Pb + (size_t)m * EVEN_IN + hq * HD + e0;
            u32x4 w[6];
#pragma unroll
            for (int hg = 4; hg < 6; ++hg) w[hg] = *(const u32x4*)(prow_ + hg * 4 * HD);
            const int t = m & (SEQ - 1); const int prow = t >> 6, pcol = t & 63;
            const float* tab = (i0 < 32) ? (rowtab + (prow * 32 + i0) * 2) : (coltab + (pcol * 32 + (i0 - 32)) * 2);
            f32x4 tb[4];
#pragma unroll
            for (int q = 0; q < 4; ++q) tb[q] = *(const f32x4*)(tab + 4 * q);
#pragma unroll
            for (int hg = 4; hg < 6; ++hg) {
                const int hd = hg * 4 + hq;
                const bool is_qa = hg < 2, is_ka = (hg == 4 && hq < 2), is_v = (hg >= 4 && hq >= 2);
                const bool do_norm = is_qa || is_ka, do_rope = !is_v && !isctx;
                float v[8] = {bf_lo(w[hg].x), bf_hi(w[hg].x), bf_lo(w[hg].y), bf_hi(w[hg].y), bf_lo(w[hg].z), bf_hi(w[hg].z), bf_lo(w[hg].w), bf_hi(w[hg].w)};
                if (hg < 2 || hg == 4) {
                    float ss = 0.f;
#pragma unroll
                    for (int e = 0; e < 8; ++e) ss += v[e] * v[e];
                    ss += __shfl_xor(ss, 1); ss += __shfl_xor(ss, 2); ss += __shfl_xor(ss, 4); ss += __shfl_xor(ss, 8);
                    if (do_norm) { const float rstd = 1.0f / sqrtf(ss * (1.f / HD) + EPS);
#pragma unroll
                        for (int e = 0; e < 8; ++e) v[e] = v[e] * rstd * (is_qa ? gq[e] : gk[e]); }
                }
                float r[8];
#pragma unroll
                for (int e = 0; e < 8; ++e) { const float oth = __shfl_xor(v[e], 8); float cs = 1.f, sn = 0.f; if (do_rope) { cs = tb[e >> 1][(e & 1) * 2]; sn = tb[e >> 1][(e & 1) * 2 + 1]; }
                    r[e] = upper ? (v[e] * cs + oth * sn) : (v[e] * cs - oth * sn); }
                (void)hd;
                if (!is_v && (!isctx || is_ka)) { u32x4 o; o.x = cvt_pk_bf16(r[0], r[1]); o.y = cvt_pk_bf16(r[2], r[3]); o.z = cvt_pk_bf16(r[4], r[5]); o.w = cvt_pk_bf16(r[6], r[7]); *(u32x4*)(prow_ + hg * 4 * HD) = o; }
            }
        }
    }
    SEAM(4);
    if (IN(5)) REP(5) { PHASE_PTRS
        const float* sink = args.in[11];
#define ATT_UNIT_SETUP const int uu = u & 1023; const int combo = (uu & 255) >> 6, qb = uu & 63, gq = uu >> 8;   \
            const int b = combo >> 1, kv = combo & 1; const long lat0 = (long)b * SEQ, ctx0 = (long)MLAT + (long)b * CTX; const int q0 = qb * 256; \
            const bf16_t* Qp = Pb + (size_t)(lat0 + q0) * EVEN_IN + COL_Q + head * HD; const bf16_t* Zp = Pb + (size_t)(lat0 + q0) * EVEN_IN + COL_Z + head * HD; \
            bf16_t* Yp = Yb + (size_t)(lat0 + q0) * DM + head * HD;
        if (ATT_SEL & 1) for (int u = vcu; u < 1024; u += G) {
            const int head = (((u & 255) >> 6) & 1) * 4 + (u >> 8);
            ATT_UNIT_SETUP
            att::attn_unit<false>(Qp, Pb + COL_KA + kv * HD, Pb + COL_VA + kv * HD, Zp, Yp, lat0, ctx0, q0, 0.f, args.in[9], rowtab, coltab, (char*)lds);
        }
        asm volatile("" ::: "memory");
        if (ATT_SEL & 2) for (int u = 1024 + vcu; u < 2048; u += G) {
            const int head = 8 + (((u & 255) >> 6) & 1) * 4 + ((u & 1023) >> 8);
            ATT_UNIT_SETUP
            att::attn_unit<true>(Qp, Pb + COL_KB + kv * HD, Pb + COL_VB + kv * HD, Zp, Yp, lat0, ctx0, q0, sink[kv * 4 + gq], args.in[9], rowtab, coltab, (char*)lds);
        }
#undef ATT_UNIT_SETUP
    }
    SEAM(5);
    if (IN(6)) REP(6) { PHASE_PTRS
        pg8::Gemm g{Yb, W0out, MLAT, DM, DM, DM, DM, 1 << 20}; pg8::StaticOrder S; S.init(MLAT, DM, G, bx);
        pg8::EpiMk E{Tb, DM, 1 << 30, nullptr, nullptr, 0};
        pg8::gemm_phase<pg8::EpiMk, pg8::StaticOrder, true, true>((LAS unsigned char*)lds, g, S, E);
    }
    SEAM(6);
    if (IN(7)) REP(7) { PHASE_PTRS
        for (int m = gw; m < MLAT; m += NGW) {
            const int b = m / SEQ; const float* m0 = mod + (size_t)b * 3 * DM; const float* m1 = mod + (size_t)(3 + b) * 3 * DM;
            postnorm_row<true>(Tb + (size_t)m * DM, XIN + (size_t)m * DM, args.in[7], m0 + 2 * DM, out + (size_t)m * DM, args.in[15], m1, m1 + DM, Hb + (size_t)m * DM, lane);
        }
    }
    SEAM(7);
    if (IN(8)) REP(8) { PHASE_PTRS
        pg8::Gemm g{Hb, W1in, MLAT, ODD_IN, DM, DM, DM, 1 << 20}; pg8::StaticOrder S; S.init(MLAT, ODD_IN, G, bx);
        pg8::EpiMk E{Pb, ODD_IN, DM, nullptr, nullptr, 0};
        pg8::gemm_phase<pg8::EpiMk, pg8::StaticOrder, true, true>((LAS unsigned char*)lds, g, S, E);
    }
    SEAM(8);
    if (IN(9)) REP(9) { PHASE_PTRS
        const int cg8 = (tid & 255) * 8, g = __builtin_amdgcn_readfirstlane(cg8 >> 9);
        for (int ch = bx; ch < MLAT / 16; ch += G) {
            const int m0 = ch * 16 + (tid >> 8) * 8, t0 = m0 & (SEQ - 1); const size_t base = (size_t)(m0 - t0);
            if (g == 0) pool_chunk<1>(Pb, Hb, base, t0, cg8); else if (g == 1) pool_chunk<2>(Pb, Hb, base, t0, cg8);
            else if (g == 2) pool_chunk<4>(Pb, Hb, base, t0, cg8); else pool_chunk<8>(Pb, Hb, base, t0, cg8);
        }
    }
    SEAM(9);
    if (IN(10)) REP(10) { PHASE_PTRS
        pg8::Gemm g{Hb, Wpool, MLAT, DM, 512, DM, 512, 2}; pg8::StaticOrder S; S.init(MLAT, DM, G, bx);
        pg8::EpiMk E{Yb, DM, 1 << 30, args.in[19], Pb + DM, ODD_IN};
        pg8::gemm_phase<pg8::EpiMk, pg8::StaticOrder, true, true>((LAS unsigned char*)lds, g, S, E);
    }
    SEAM(10);
    if (IN(11)) REP(11) { PHASE_PTRS
        pg8::Gemm g{Yb, W1out, MLAT, DM, DM, DM, DM, 1 << 20}; pg8::StaticOrder S; S.init(MLAT, DM, G, bx);
        pg8::EpiMk E{Tb, DM, 1 << 30, nullptr, nullptr, 0};
        pg8::gemm_phase<pg8::EpiMk, pg8::StaticOrder, true, true>((LAS unsigned char*)lds, g, S, E);
    }
    SEAM(11);
    if (IN(12)) { PHASE_PTRS
        for (int m = gw; m < MLAT; m += NGW) {
            const int b = m / SEQ; const float* m1 = mod + (size_t)(3 + b) * 3 * DM;
            postnorm_row<false>(Tb + (size_t)m * DM, out + (size_t)m * DM, args.in[16], m1 + 2 * DM, out + (size_t)m * DM, nullptr, nullptr, nullptr, nullptr, lane);
        }
    }
#ifdef MK_XSYNC
    for (int i = 0; i < MK_XSYNC; ++i) xcd_barrier(bar);
#endif
#undef IN
#undef SEAM
#undef modp
#undef mod
#undef rowtab
#undef coltab
#undef W0in
#undef W0out
#undef W1in
#undef Wpool
#undef W1out
#undef Hb
#undef Pb
#undef Yb
#undef Tb
#undef XIN
#undef cvec
#undef ctx
#undef c_ctx
#undef out
}

constexpr int N_PHASES = 13;
#ifndef MK_PER_PHASE
#define MK_PER_PHASE 0
#endif
extern "C" void kernel_launch(void* const* d_in, const int* in_sizes, int n_in, void* d_out, int out_size, void* d_ws, size_t ws_size, hipStream_t stream) {
    static int grid = 0;
    if (grid == 0) {
        if (n_in != 21 || out_size != MLAT * DM || ws_size < WS_END) { fprintf(stderr, "kernel_launch: unexpected shapes (n_in %d out %d ws %zu)\n", n_in, out_size, ws_size); grid = -1; return; }
        int dev = 0, cus = 0, per_cu = 0;
        hipGetDevice(&dev); hipDeviceGetAttribute(&cus, hipDeviceAttributeMultiprocessorCount, dev);
        if (hipFuncSetAttribute((const void*)mk_fwd, hipFuncAttributeMaxDynamicSharedMemorySize, LDS_BYTES) != hipSuccess) { fprintf(stderr, "kernel_launch: hipFuncSetAttribute failed\n"); grid = -1; return; }
        if (hipOccupancyMaxActiveBlocksPerMultiprocessor(&per_cu, (const void*)mk_fwd, 512, LDS_BYTES) != hipSuccess || per_cu < 1) per_cu = 1;
        (void)hipGetLastError();
        grid = cus * per_cu;
    }
    if (grid < 0) return;
    (void)hipMemsetAsync((char*)d_ws + WS_BAR, 0, XCD_BAR_WORDS * 4, stream);
    Args a{};
    for (int i = 0; i < 21; ++i) a.in[i] = (const float*)d_in[i];
    a.out = (float*)d_out; a.ws = (unsigned char*)d_ws;
    for (int f = 0; f < 32; ++f) { const double inv = pow(10000.0, -(double)f / 32.0); a.cs1[f] = cos(inv); a.sn1[f] = sin(inv); }
#if MK_PER_PHASE
    for (int p = 0; p < N_PHASES; ++p) { a.ph_lo = p; a.ph_hi = p + 1; hipLaunchKernelGGL(mk_fwd, dim3(grid), dim3(512), LDS_BYTES, stream, a); }
#else
    a.ph_lo = 0; a.ph_hi = N_PHASES;
    void* kargs[] = {&a};
    hipError_t e = hipLaunchCooperativeKernel((const void*)mk_fwd, dim3(grid), dim3(512), kargs, LDS_BYTES, stream);
    if (e != hipSuccess) fprintf(stderr, "kernel_launch: cooperative launch failed: %s (grid %d)\n", hipGetErrorString(e), grid);
#endif
}
```

```cpp
#include <hip/hip_runtime.h>
#include <hip/hip_cooperative_groups.h>
#include <cstdio>
#include <cstdint>
#include <cmath>
namespace cg = cooperative_groups;

#define LAS __attribute__((address_space(3)))
typedef unsigned short bf16_t;
typedef short bf16x8 __attribute__((ext_vector_type(8)));
typedef short s16x4 __attribute__((ext_vector_type(4)));
typedef float f32x4 __attribute__((ext_vector_type(4)));
typedef float f32x16 __attribute__((ext_vector_type(16)));
typedef unsigned u32x4 __attribute__((ext_vector_type(4)));
typedef unsigned u32x2 __attribute__((ext_vector_type(2)));

__device__ __forceinline__ unsigned cvt_pk_bf16(float lo, float hi) { unsigned r; asm volatile("v_cvt_pk_bf16_f32 %0, %1, %2" : "=v"(r) : "v"(lo), "v"(hi)); return r; }
__device__ __forceinline__ float bf_lo(unsigned w) { return __uint_as_float(w << 16); }
__device__ __forceinline__ float bf_hi(unsigned w) { return __uint_as_float(w & 0xffff0000u); }
__device__ __forceinline__ float bf2f(bf16_t h) { return __uint_as_float(((unsigned)h) << 16); }
__device__ __forceinline__ float silu_f(float v) { return v * __builtin_amdgcn_rcpf(1.f + __builtin_amdgcn_exp2f(-v * 1.4426950408889634f)); }

constexpr int DM = 2048, NB = 2, SEQ = 16384, CTX = 256, HD = 128;
constexpr int MLAT = NB * SEQ;
constexpr int MALL = MLAT + NB * CTX;
constexpr int EVEN_IN = 5120, ODD_IN = 4096;
constexpr int COL_Q = 0, COL_KA = 2048, COL_VA = 2304, COL_KB = 2560, COL_VB = 2816, COL_Z = 3072;
constexpr float EPS = 1e-6f;

namespace pg8 {
constexpr int BM = 256, BK = 64, HALF = 128, HTB = HALF * BK * 2, STAGE_BYTES = 8 * HTB, NXCD = 8, WGM = 8;
__host__ __device__ __forceinline__ int lds_byte(int r, int c) { const int st = (r >> 4) * 2 + (c >> 5), rr = r & 15, cc = c & 31, ob = rr * 64 + cc * 2; return st * 1024 + (ob ^ (((ob >> 9) & 1) << 5)); }
__host__ __device__ __forceinline__ void stage_rc(int b, int& R, int& C) { const int st = b / 1024, sb = b % 1024, swz = sb ^ (((sb >> 9) & 1) << 5); R = (st >> 1) * 16 + swz / 64; C = (st & 1) * 32 + (swz % 64) / 2; }
__host__ __device__ __forceinline__ int perm32(int rho) { const int n = rho >> 4, i = rho & 15; return 8 * (i >> 2) + 4 * n + (i & 3); }

struct Unit { int pm, pn; };
struct Gemm { const bf16_t* A; const bf16_t* Bt; int M, N, K, lda, ldb, gdiv; };

struct StaticOrder {
    int nM, nN, nwg, G, c;
    __host__ __device__ void init(int M, int N, int G_, int c_) { nM = M / BM; nN = N / BM; nwg = nM * nN; G = G_; c = c_; }
    __host__ __device__ bool next(int i, Unit& u) const {
        const long L = (long)i * G + c; if (L >= nwg) return false;
        int wgid = (int)L; { const int q = nwg / NXCD, r = nwg % NXCD, xcd = wgid % NXCD, off = wgid / NXCD; wgid = (xcd < r ? xcd * (q + 1) : r * (q + 1) + (xcd - r) * q) + off; }
        const int nig = WGM * nN, gid = wgid / nig, fm = gid * WGM, gsz = (nM - fm) < WGM ? (nM - fm) : WGM;
        u.pm = fm + ((wgid % nig) % gsz); u.pn = (wgid % nig) / gsz; return true;
    }
    __device__ __forceinline__ void a_ready(const Unit&) const {}
    __device__ __forceinline__ void done(const Unit&) const {}
};

struct EpiMk {
    static constexpr bool PERM = true, AFTER_DRAIN = false;
    bf16_t* O; int ldc; int silu_from; const float* cscale; const bf16_t* mul; int ldmul;
    __device__ __forceinline__ void operator()(const f32x4 (&acc)[2][2][4][2], const Unit& u, int wr, int wc, int fr, int fq) const {
        const int row0 = u.pm * BM + wr * 64 + fr; const int colt = u.pn * BM; const int col0 = colt + wc * 32 + 8 * fq;
        const bool dosilu = colt >= silu_from;
        f32x4 cs[2][2];
#pragma unroll
        for (int bj = 0; bj < 2; ++bj)
#pragma unroll
            for (int n = 0; n < 2; ++n) cs[bj][n] = cscale ? *(const f32x4*)(cscale + col0 + bj * HALF + 4 * n) : (f32x4){1.f, 1.f, 1.f, 1.f};
#pragma unroll
        for (int ai = 0; ai < 2; ++ai)
#pragma unroll
            for (int m = 0; m < 4; ++m) { const size_t row = (size_t)(row0 + ai * HALF + m * 16); bf16_t* rowp = O + row * ldc + col0;
#pragma unroll
                for (int bj = 0; bj < 2; ++bj) { f32x4 v0 = acc[ai][bj][m][0] * cs[bj][0], v1 = acc[ai][bj][m][1] * cs[bj][1];
                    if (mul) { const u32x4 mv = *(const u32x4*)(mul + row * ldmul + col0 + bj * HALF);
                        v0[0] *= bf_lo(mv.x); v0[1] *= bf_hi(mv.x); v0[2] *= bf_lo(mv.y); v0[3] *= bf_hi(mv.y); v1[0] *= bf_lo(mv.z); v1[1] *= bf_hi(mv.z); v1[2] *= bf_lo(mv.w); v1[3] *= bf_hi(mv.w); }
                    if (dosilu) {
#pragma unroll
                        for (int e = 0; e < 4; ++e) { v0[e] = silu_f(v0[e]); v1[e] = silu_f(v1[e]); } }
                    u32x4 w; w.x = cvt_pk_bf16(v0[0], v0[1]); w.y = cvt_pk_bf16(v0[2], v0[3]); w.z = cvt_pk_bf16(v1[0], v1[1]); w.w = cvt_pk_bf16(v1[2], v1[3]);
                    *(u32x4*)(rowp + bj * HALF) = w; } }
    }
};

#define PG8_LAS LAS
template <class Epi, class Sched, bool ALIGN_EPI = false, bool SP2 = false>
__device__ __forceinline__ void gemm_phase(PG8_LAS unsigned char* lds, const Gemm g, const Sched& S, const Epi& E) {
    const int tid = threadIdx.x, wid = __builtin_amdgcn_readfirstlane(tid >> 6), lane = tid & 63, wr = wid >> 2, wc = wid & 3, fr = lane & 15, fq = lane >> 4;
    const int K = g.K, nt = K / BK;
    unsigned voffA[2], voffB[2];
#pragma unroll
    for (int i = 0; i < 2; ++i) { int R, C; stage_rc(tid * 16 + i * 8192, R, C); const int Rb = Epi::PERM ? ((R & ~31) + perm32(R & 31)) : R;
        voffA[i] = (unsigned)(R * g.lda + C) * 2u; voffB[i] = (unsigned)(Rb * g.ldb + C) * 2u; }
    const size_t kstep = (size_t)(BK * 2);
    const size_t hstepA = (size_t)HALF * g.lda * 2, hstepB = (size_t)HALF * g.ldb * 2;
    const size_t tstepA = 2 * hstepA, tstepB = 2 * hstepB;
    const unsigned ldsw = (unsigned)wid * 1024u;
    const int aoff = lds_byte(wr * 64 + fr, fq * 8), boff = lds_byte(wc * 32 + fr, fq * 8);
#define PG8_SA(b, h) (((b) * 2 + (h)) * HTB)
#define PG8_SB(b, h) ((4 + (b) * 2 + (h)) * HTB)
#define PG8_STAGE(bufoff, gbase, voff) do { _Pragma("unroll") for (int _i = 0; _i < 2; ++_i) \
        __builtin_amdgcn_global_load_lds((const unsigned*)((const char*)(gbase) + (voff)[_i]), (PG8_LAS unsigned*)(lds + (bufoff) + ldsw + _i * 8192), 16, 0, 0); } while (0)
#define PG8_LDA(dst, b, h) do { _Pragma("unroll") for (int m = 0; m < 4; ++m) _Pragma("unroll") for (int k = 0; k < 2; ++k) dst[m][k] = *(const PG8_LAS bf16x8*)(lds + PG8_SA(b, h) + aoff + m * 2048 + k * 1024); } while (0)
#define PG8_LDB(dst, b, h) do { _Pragma("unroll") for (int n = 0; n < 2; ++n) _Pragma("unroll") for (int k = 0; k < 2; ++k) dst[n][k] = *(const PG8_LAS bf16x8*)(lds + PG8_SB(b, h) + boff + n * 2048 + k * 1024); } while (0)
#define PG8_MMA(ai, bj, At, Bt) do { __builtin_amdgcn_s_setprio(1); _Pragma("unroll") for (int m = 0; m < 4; ++m) _Pragma("unroll") for (int n = 0; n < 2; ++n) _Pragma("unroll") for (int k = 0; k < 2; ++k) \
        acc[ai][bj][m][n] = __builtin_amdgcn_mfma_f32_16x16x32_bf16(Bt[n][k], At[m][k], acc[ai][bj][m][n], 0, 0, 0); __builtin_amdgcn_s_setprio(0); } while (0)
#define PG8_WAIT_V(n) asm volatile("s_waitcnt vmcnt(" #n ")" ::: "memory")
#define PG8_WAIT_L(n) asm volatile("s_waitcnt lgkmcnt(" #n ")" ::: "memory")
#define PG8_BAR __builtin_amdgcn_s_barrier()
#define PG8_SCHED __builtin_amdgcn_sched_barrier(0)
    Unit cur, nxt; int ui = 0;
    if (!S.next(0, cur)) return;
    f32x4 acc[2][2][4][2];
#pragma unroll
    for (int a = 0; a < 2; ++a)
#pragma unroll
        for (int b = 0; b < 2; ++b)
#pragma unroll
            for (int m = 0; m < 4; ++m)
#pragma unroll
                for (int n = 0; n < 2; ++n) acc[a][b][m][n] = (f32x4){0.f, 0.f, 0.f, 0.f};
    bf16x8 At[4][2], B0[2][2], B1[2][2];
    const char* cA = (const char*)g.A + (size_t)cur.pm * tstepA + (size_t)(cur.pn / g.gdiv) * (size_t)K * 2; const char* cB = (const char*)g.Bt + (size_t)cur.pn * tstepB;
    S.a_ready(cur);
    if constexpr (SP2) {
        PG8_STAGE(PG8_SB(0, 0), cB, voffB); PG8_STAGE(PG8_SB(0, 1), cB + hstepB, voffB); PG8_STAGE(PG8_SA(0, 0), cA, voffA); PG8_STAGE(PG8_SA(0, 1), cA + hstepA, voffA);
        if (wr == 1) PG8_BAR;
        PG8_WAIT_V(2); PG8_BAR;
        PG8_STAGE(PG8_SB(1, 0), cB + kstep, voffB); PG8_STAGE(PG8_SA(1, 0), cA + kstep, voffA); PG8_STAGE(PG8_SB(1, 1), cB + hstepB + kstep, voffB);
        PG8_WAIT_V(6); PG8_BAR;
    } else {
        PG8_STAGE(PG8_SB(0, 0), cB, voffB); PG8_STAGE(PG8_SA(0, 0), cA, voffA); PG8_STAGE(PG8_SB(0, 1), cB + hstepB, voffB); PG8_STAGE(PG8_SA(0, 1), cA + hstepA, voffA);
        if (wr == 1) PG8_BAR;
        PG8_WAIT_V(4); PG8_BAR;
        PG8_STAGE(PG8_SB(1, 0), cB + kstep, voffB); PG8_STAGE(PG8_SA(1, 0), cA + kstep, voffA); PG8_STAGE(PG8_SB(1, 1), cB + hstepB + kstep, voffB);
        PG8_WAIT_V(6); PG8_BAR;
    }
    for (;;) {
        const bool has_next = S.next(ui + 1, nxt);
        const char* nA = has_next ? (const char*)g.A + (size_t)nxt.pm * tstepA + (size_t)(nxt.pn / g.gdiv) * (size_t)K * 2 : cA; const char* nB = has_next ? (const char*)g.Bt + (size_t)nxt.pn * tstepB : cB;
        for (int t = 0; t < nt; t += 2) {
            const bool last = (t == nt - 2);
            const char* a1 = cA + (size_t)(t + 1) * kstep;
            const char* a2 = last ? nA : cA + (size_t)(t + 2) * kstep; const char* b2 = last ? nB : cB + (size_t)(t + 2) * kstep;
            const char* a3 = a2 + kstep; const char* b3 = b2 + kstep;
            if (last && has_next) S.a_ready(nxt);
            if constexpr (SP2) {
            PG8_LDB(B0, 0, 0); PG8_LDB(B1, 0, 1); PG8_SCHED; PG8_LDA(At, 0, 0); PG8_STAGE(PG8_SA(1, 1), a1 + hstepA, voffA);
            PG8_WAIT_V(8); PG8_WAIT_L(0); PG8_BAR; PG8_MMA(0, 0, At, B0); PG8_MMA(0, 1, At, B1); PG8_BAR; PG8_SCHED;
            PG8_LDA(At, 0, 1); PG8_STAGE(PG8_SB(0, 0), b2, voffB); PG8_STAGE(PG8_SB(0, 1), b2 + hstepB, voffB); PG8_STAGE(PG8_SA(0, 0), a2, voffA);
            PG8_WAIT_V(8); PG8_WAIT_L(0); PG8_BAR; PG8_MMA(1, 0, At, B0); PG8_MMA(1, 1, At, B1); PG8_BAR; PG8_SCHED;
            PG8_LDB(B0, 1, 0); PG8_LDB(B1, 1, 1); PG8_SCHED; PG8_LDA(At, 1, 0); PG8_STAGE(PG8_SA(0, 1), a2 + hstepA, voffA);
            PG8_WAIT_V(8); PG8_WAIT_L(0); PG8_BAR; PG8_MMA(0, 0, At, B0); PG8_MMA(0, 1, At, B1); PG8_BAR; PG8_SCHED;
            PG8_LDA(At, 1, 1); PG8_STAGE(PG8_SB(1, 0), b3, voffB); PG8_STAGE(PG8_SB(1, 1), b3 + hstepB, voffB); PG8_STAGE(PG8_SA(1, 0), a3, voffA);
            PG8_WAIT_V(8); PG8_WAIT_L(0); PG8_BAR; PG8_MMA(1, 0, At, B0); PG8_MMA(1, 1, At, B1); PG8_BAR; PG8_SCHED;
            } else {
            PG8_LDB(B0, 0, 0); PG8_SCHED; PG8_LDA(At, 0, 0); PG8_STAGE(PG8_SA(1, 1), a1 + hstepA, voffA);
            PG8_WAIT_L(8); PG8_BAR; PG8_WAIT_L(0); PG8_MMA(0, 0, At, B0); PG8_BAR; PG8_SCHED;
            PG8_LDB(B1, 0, 1); PG8_STAGE(PG8_SB(0, 0), b2, voffB);
            PG8_BAR; PG8_WAIT_L(0); PG8_MMA(0, 1, At, B1); PG8_BAR;
            PG8_LDA(At, 0, 1); PG8_STAGE(PG8_SA(0, 0), a2, voffA);
            PG8_BAR; PG8_WAIT_L(0); PG8_MMA(1, 0, At, B0); PG8_BAR; PG8_SCHED;
            PG8_STAGE(PG8_SB(0, 1), b2 + hstepB, voffB);
            PG8_WAIT_V(6); PG8_BAR; PG8_MMA(1, 1, At, B1); PG8_BAR;
            PG8_LDB(B0, 1, 0); PG8_SCHED; PG8_LDA(At, 1, 0); PG8_STAGE(PG8_SA(0, 1), a2 + hstepA, voffA);
            PG8_WAIT_L(8); PG8_BAR; PG8_WAIT_L(0); PG8_MMA(0, 0, At, B0); PG8_BAR; PG8_SCHED;
            PG8_LDB(B1, 1, 1); PG8_STAGE(PG8_SB(1, 0), b3, voffB);
            PG8_BAR; PG8_WAIT_L(0); PG8_MMA(0, 1, At, B1); PG8_BAR;
            PG8_LDA(At, 1, 1); PG8_STAGE(PG8_SA(1, 0), a3, voffA);
            PG8_BAR; PG8_WAIT_L(0); PG8_MMA(1, 0, At, B0); PG8_BAR; PG8_SCHED;
            PG8_STAGE(PG8_SB(1, 1), b3 + hstepB, voffB);
            PG8_WAIT_V(6); PG8_BAR; PG8_MMA(1, 1, At, B1); PG8_BAR;
            }
        }
        if constexpr (ALIGN_EPI) { if (wr == 0) PG8_BAR; }
        if constexpr (!Epi::AFTER_DRAIN) { E(acc, cur, wr, wc, fr, fq); S.done(cur); }
        if (!has_next) break;
#pragma unroll
        for (int a = 0; a < 2; ++a)
#pragma unroll
            for (int b = 0; b < 2; ++b)
#pragma unroll
                for (int m = 0; m < 4; ++m)
#pragma unroll
                    for (int n = 0; n < 2; ++n) acc[a][b][m][n] = (f32x4){0.f, 0.f, 0.f, 0.f};
        cur = nxt; cA = nA; cB = nB; ++ui;
        if constexpr (ALIGN_EPI) { if (wr == 1) PG8_BAR; }
    }
    PG8_WAIT_V(0);
    if constexpr (!ALIGN_EPI) { if (wr == 0) PG8_BAR; }
    PG8_BAR;
    if constexpr (Epi::AFTER_DRAIN) { E.fused(acc, cur, wr, wc, fr, fq, lds, wid, lane); S.done(cur); }
#undef PG8_SA
#undef PG8_SB
#undef PG8_STAGE
#undef PG8_LDA
#undef PG8_LDB
#undef PG8_MMA
#undef PG8_WAIT_V
#undef PG8_WAIT_L
#undef PG8_BAR
#undef PG8_SCHED
}
}

namespace att {
constexpr int D = 128, NW = 8, QBLK = 32, KVBLK = 64, LDP = EVEN_IN;
constexpr float SCALE = 0.088388347648318440f, THR = 8.f;
constexpr size_t SHM_V = KVBLK * D * 2, SHM_K = KVBLK * D * 2, SHM_ATTN = 2 * SHM_V + 2 * SHM_K + NW * 64 * 4;
#define KSWZ(row, colB) ((row) * 256 + ((colB) ^ (((row) & 7) << 4)))
#define SBAR() __builtin_amdgcn_sched_barrier(0)
__device__ __forceinline__ int crow(int r, int hi) { return (r & 3) + 8 * (r >> 2) + 4 * hi; }

__device__ __forceinline__ void partialSM(f32x16& p0, f32x16& p1, float& m_reg, float& mn, float& alpha) {
  constexpr float C = SCALE * 1.4426950408889634f;
  float pmax = p0[0];
#pragma unroll
  for (int r = 1; r < 16; ++r) pmax = fmaxf(pmax, p0[r]);
#pragma unroll
  for (int r = 0; r < 16; ++r) pmax = fmaxf(pmax, p1[r]);
  { auto rr = __builtin_amdgcn_permlane32_swap(__float_as_uint(pmax), __float_as_uint(pmax), false, false);
    pmax = fmaxf(__uint_as_float(rr[0]), __uint_as_float(rr[1])); }
  if (__builtin_expect(__all(pmax - m_reg <= THR / SCALE), 1)) { mn = m_reg; alpha = 1.f; }
  else { mn = fmaxf(m_reg, pmax); alpha = __builtin_amdgcn_exp2f((m_reg - mn) * C); m_reg = mn; }
  float mnC = -mn * C;
#pragma unroll
  for (int r = 0; r < 16; ++r) p0[r] = fmaf(p0[r], C, mnC);
#pragma unroll
  for (int r = 0; r < 16; ++r) p1[r] = fmaf(p1[r], C, mnC);
#pragma unroll
  for (int r = 0; r < 16; ++r) p0[r] = __builtin_amdgcn_exp2f(p0[r]);
}
__device__ __forceinline__ void finishSM(f32x16& p0, f32x16& p1, float alpha, float& l_reg, bf16x8& pa0, bf16x8& pa1, bf16x8& pa2, bf16x8& pa3) {
#pragma unroll
  for (int r = 0; r < 16; ++r) p1[r] = __builtin_amdgcn_exp2f(p1[r]);
  float ps = 0;
#pragma unroll
  for (int r = 0; r < 16; ++r) ps += p0[r];
#pragma unroll
  for (int r = 0; r < 16; ++r) ps += p1[r];
  { auto rr = __builtin_amdgcn_permlane32_swap(__float_as_uint(ps), __float_as_uint(ps), false, false);
    ps = __uint_as_float(rr[0]) + __uint_as_float(rr[1]); }
  l_reg = l_reg * alpha + ps;
#define PK4(P, BASE, OUT) do { unsigned a0 = cvt_pk_bf16(P[BASE + 0], P[BASE + 1]), a1 = cvt_pk_bf16(P[BASE + 2], P[BASE + 3]);   \
    unsigned b0 = cvt_pk_bf16(P[BASE + 4], P[BASE + 5]), b1 = cvt_pk_bf16(P[BASE + 6], P[BASE + 7]);                              \
    auto r0 = __builtin_amdgcn_permlane32_swap(a0, b0, false, false); auto r1 = __builtin_amdgcn_permlane32_swap(a1, b1, false, false); \
    u32x4 w = {r0[0], r1[0], r0[1], r1[1]}; OUT = *reinterpret_cast<bf16x8*>(&w); } while (0)
  PK4(p0, 0, pa0); PK4(p0, 8, pa1); PK4(p1, 0, pa2); PK4(p1, 8, pa3);
#undef PK4
}
__device__ __forceinline__ void qkt(f32x16& p0, f32x16& p1, const bf16_t* Ks, const bf16x8* qr, int r32, int hi) {
  p0 = f32x16{}; p1 = f32x16{};
#pragma unroll
  for (int d0 = 0; d0 < 8; ++d0) { int cb = (d0 * 16 + hi * 8) * 2;
    bf16x8 b0 = *reinterpret_cast<const bf16x8*>((const char*)Ks + KSWZ(r32, cb));
    bf16x8 b1 = *reinterpret_cast<const bf16x8*>((const char*)Ks + KSWZ(32 + r32, cb));
    p0 = __builtin_amdgcn_mfma_f32_32x32x16_bf16(b0, qr[d0], p0, 0, 0, 0);
    p1 = __builtin_amdgcn_mfma_f32_32x32x16_bf16(b1, qr[d0], p1, 0, 0, 0); }
}
__device__ __forceinline__ int v_st(int k, int c) { const int kk = (k & ~0xC) | ((k & 4) << 1) | ((k & 8) >> 1); return ((kk >> 3) * 4 + (c >> 5)) * 512 + ((kk & 7) * 32 + (c & 31)) * 2; }
__device__ __forceinline__ int v_rd_base(int lane) { return ((lane & 3) << 3) | (((lane >> 2) & 3) << 6) | (((lane >> 4) & 1) << 5) | (((lane >> 5) & 1) << 8); }
constexpr int v_rd_off(int d0, int ks, int half) { return d0 * 512 + ks * 4096 + half * 2048; }
template <int OFF> __device__ __forceinline__ s16x4 tr_read(int vb) {
  s16x4 r; asm volatile("ds_read_b64_tr_b16 %0, %1 offset:%2" : "=&v"(r) : "v"(vb), "i"(OFF) : "memory"); return r;
}
template <int D0> __device__ __forceinline__ void pv_one(f32x16& od, int vb, bf16x8 pa0, bf16x8 pa1, bf16x8 pa2, bf16x8 pa3) {
  const s16x4 l0 = tr_read<v_rd_off(D0, 0, 0)>(vb), h0 = tr_read<v_rd_off(D0, 0, 1)>(vb), l1 = tr_read<v_rd_off(D0, 1, 0)>(vb), h1 = tr_read<v_rd_off(D0, 1, 1)>(vb);
  const s16x4 l2 = tr_read<v_rd_off(D0, 2, 0)>(vb), h2 = tr_read<v_rd_off(D0, 2, 1)>(vb), l3 = tr_read<v_rd_off(D0, 3, 0)>(vb), h3 = tr_read<v_rd_off(D0, 3, 1)>(vb);
  asm volatile("s_waitcnt lgkmcnt(0)" ::: "memory"); SBAR();
#define PK(L, H) (bf16x8){L[0], L[1], L[2], L[3], H[0], H[1], H[2], H[3]}
  od = __builtin_amdgcn_mfma_f32_32x32x16_bf16(pa0, PK(l0, h0), od, 0, 0, 0);
  od = __builtin_amdgcn_mfma_f32_32x32x16_bf16(pa1, PK(l1, h1), od, 0, 0, 0);
  od = __builtin_amdgcn_mfma_f32_32x32x16_bf16(pa2, PK(l2, h2), od, 0, 0, 0);
  od = __builtin_amdgcn_mfma_f32_32x32x16_bf16(pa3, PK(l3, h3), od, 0, 0, 0);
#undef PK
}
__device__ __forceinline__ void pv_d0(f32x16* o, int vb, bf16x8 pa0, bf16x8 pa1, bf16x8 pa2, bf16x8 pa3) {
  pv_one<0>(o[0], vb, pa0, pa1, pa2, pa3); pv_one<1>(o[1], vb, pa0, pa1, pa2, pa3); pv_one<2>(o[2], vb, pa0, pa1, pa2, pa3); pv_one<3>(o[3], vb, pa0, pa1, pa2, pa3);
}

template <bool WIN>
__device__ __forceinline__ void attn_unit(const bf16_t* __restrict__ Qb, const bf16_t* __restrict__ Kc, const bf16_t* __restrict__ Vc, const bf16_t* __restrict__ Zb,
                                          bf16_t* __restrict__ Yb, long lat0, long ctx0, int q0, float sinkv, char* lds) {
  const int tid = threadIdx.x, wid = tid >> 6, lane = tid & 63, r32 = lane & 31, hi = lane >> 5;
  bf16_t* V_lds = (bf16_t*)lds; bf16_t* K_lds = (bf16_t*)(lds + 2 * SHM_V);
  float* ws = (float*)(lds + 2 * SHM_V + 2 * SHM_K) + wid * 64; float* li_l = ws; float* al_l = ws + 32;
  float m_reg = -1e30f, l_reg = 0; f32x16 o[4] = {}; bf16x8 qr[8];
  const bf16_t* Qw = Qb + (long)(wid * QBLK + r32) * LDP + hi * 8;
#pragma unroll
  for (int d0 = 0; d0 < 8; ++d0) qr[d0] = *reinterpret_cast<const bf16x8*>(Qw + d0 * 16);
  const int sr = tid >> 4, sc = (tid & 15) * 8, vst0 = v_st(sr, sc), vst1 = v_st(32 + sr, sc);
  const int vb0 = (int)(uintptr_t)V_lds + v_rd_base(lane);
  const int tb0 = WIN ? ((q0 / 64 - 2) > 0 ? (q0 / 64 - 2) : 0) : 0;
  const int tb1 = WIN ? ((q0 / 64 + 5) < 255 ? (q0 / 64 + 5) : 255) : 0;
  const int NT = WIN ? (4 + tb1 - tb0 + 1) : (SEQ / KVBLK + CTX / KVBLK);
#define TROW(t) (WIN ? ((t) < 4 ? ctx0 + 64 * (t) : lat0 + 64 * (long)(tb0 + (t) - 4)) : ((t) < SEQ / KVBLK ? lat0 + 64 * (long)(t) : ctx0 + 64 * (long)((t) - SEQ / KVBLK)))
  struct { bf16x8 vs0, vs1, ks0, ks1; } sr_[2];
  const int ldo0 = sr * LDP + sc, ldo1 = (32 + sr) * LDP + sc;
#define SLOAD(i, t) do { const long R_ = TROW(t); const bf16_t* vt_ = Vc + R_ * LDP; const bf16_t* kt_ = Kc + R_ * LDP; \
    sr_[i].vs0 = *reinterpret_cast<const bf16x8*>(vt_ + ldo0); sr_[i].vs1 = *reinterpret_cast<const bf16x8*>(vt_ + ldo1); \
    sr_[i].ks0 = *reinterpret_cast<const bf16x8*>(kt_ + ldo0); sr_[i].ks1 = *reinterpret_cast<const bf16x8*>(kt_ + ldo1); } while (0)
#define SWRITE(b, i) do { *(bf16x8*)((char*)V_lds + (b) * SHM_V + vst0) = sr_[i].vs0;          \
    *(bf16x8*)((char*)V_lds + (b) * SHM_V + vst1) = sr_[i].vs1; int kc = sc * 2;               \
    *(bf16x8*)((char*)K_lds + (b) * SHM_K + KSWZ(sr, kc)) = sr_[i].ks0;                       \
    *(bf16x8*)((char*)K_lds + (b) * SHM_K + KSWZ(32 + sr, kc)) = sr_[i].ks1; } while (0)
#define SWAIT() asm volatile("s_waitcnt vmcnt(4)" ::: "memory")
#define RESC(a) do { if (__any((a) < 1.f)) { if (hi == 0) al_l[r32] = (a); asm volatile("s_waitcnt lgkmcnt(0)" ::: "memory"); \
    _Pragma("unroll") for (int d = 0; d < 4; ++d) _Pragma("unroll") for (int r = 0; r < 16; ++r) o[d][r] *= al_l[crow(r, hi)]; } } while (0)
#define MASKT(P0, P1, t) do { if (WIN && (t) >= 4) { const int dk_ = 64 * (tb0 + (t) - 4) - (q0 + wid * QBLK + r32); \
    _Pragma("unroll") for (int r = 0; r < 16; ++r) { const int d_ = dk_ + crow(r, hi); \
      if (d_ > 128 || d_ < -128) P0[r] = -1e30f; if (d_ + 32 > 128 || d_ + 32 < -128) P1[r] = -1e30f; } } } while (0)
  f32x16 pA0, pA1, pB0, pB1; float mnA, mnB, alA, alB; bf16x8 pa0, pa1, pa2, pa3;
  constexpr int SE = 0, SO = 1;
  SLOAD(SE, 0); asm volatile("s_waitcnt vmcnt(0)" ::: "memory"); SWRITE(0, SE); __syncthreads();
  qkt(pA0, pA1, K_lds, qr, r32, hi); MASKT(pA0, pA1, 0); partialSM(pA0, pA1, m_reg, mnA, alA);
  SLOAD(SO, 1); if (2 < NT) SLOAD(SE, 2);
  SWAIT(); SWRITE(1, SO); __syncthreads();
  for (int j = 1; j + 1 < NT; j += 2) {
    SBAR(); qkt(pB0, pB1, (bf16_t*)((char*)K_lds + SHM_K), qr, r32, hi);
    finishSM(pA0, pA1, alA, l_reg, pa0, pa1, pa2, pa3); SBAR();
    SLOAD(SO, j + 2); SBAR();
    pv_d0(o, vb0, pa0, pa1, pa2, pa3); MASKT(pB0, pB1, j); partialSM(pB0, pB1, m_reg, mnB, alB);
    __syncthreads(); SWAIT(); SWRITE(0, SE);
    RESC(alB); __syncthreads();
    SBAR(); qkt(pA0, pA1, K_lds, qr, r32, hi);
    finishSM(pB0, pB1, alB, l_reg, pa0, pa1, pa2, pa3); SBAR();
    if (j + 3 < NT) SLOAD(SE, j + 3); SBAR();
    pv_d0(o, vb0 + (int)SHM_V, pa0, pa1, pa2, pa3); MASKT(pA0, pA1, j + 1); partialSM(pA0, pA1, m_reg, mnA, alA);
    __syncthreads(); SWAIT(); SWRITE(1, SO);
    RESC(alA); __syncthreads();
  }
  SBAR(); qkt(pB0, pB1, (bf16_t*)((char*)K_lds + SHM_K), qr, r32, hi);
  finishSM(pA0, pA1, alA, l_reg, pa0, pa1, pa2, pa3); SBAR();
  pv_d0(o, vb0, pa0, pa1, pa2, pa3); MASKT(pB0, pB1, NT - 1); partialSM(pB0, pB1, m_reg, mnB, alB);
  __syncthreads(); RESC(alB);
  finishSM(pB0, pB1, alB, l_reg, pa0, pa1, pa2, pa3); SBAR();
  pv_d0(o, vb0 + (int)SHM_V, pa0, pa1, pa2, pa3);
  if (WIN) l_reg += __builtin_amdgcn_exp2f(sinkv * 1.4426950408889634f - m_reg * (SCALE * 1.4426950408889634f));
  if (hi == 0) li_l[r32] = l_reg; asm volatile("s_waitcnt lgkmcnt(0)" ::: "memory");
  float rli[16];
#pragma unroll
  for (int r = 0; r < 16; ++r) rli[r] = __builtin_amdgcn_rcpf(li_l[4 * hi + (r & 3) + 8 * (r >> 2)]);
  __syncthreads();
  { bf16_t* stg = (bf16_t*)lds + wid * (QBLK * D); bf16_t* sp = stg + (4 * hi) * D + r32;
#pragma unroll
    for (int r = 0; r < 16; ++r) {
#pragma unroll
      for (int d0 = 0; d0 < 4; ++d0) { const float y = o[d0][r] * rli[r]; sp[((r & 3) + 8 * (r >> 2)) * D + d0 * 32] = (bf16_t)(cvt_pk_bf16(y, y) & 0xffffu); } }
    asm volatile("s_waitcnt lgkmcnt(0)" ::: "memory");
    const int row0 = lane >> 4, ch = (lane & 15) * 8;
    const bf16_t* Zw = Zb + (long)(wid * QBLK + row0) * LDP + ch; bf16_t* Yw = Yb + (long)(wid * QBLK + row0) * DM + ch; const bf16_t* sq = stg + row0 * D + ch;
#pragma unroll
    for (int i = 0; i < 8; ++i) {
      const u32x4 v = *(const u32x4*)(sq + i * 4 * D); const u32x4 z = *(const u32x4*)(Zw + (long)i * 4 * LDP);
      u32x4 w; w.x = cvt_pk_bf16(bf_lo(v.x) * bf_lo(z.x), bf_hi(v.x) * bf_hi(z.x)); w.y = cvt_pk_bf16(bf_lo(v.y) * bf_lo(z.y), bf_hi(v.y) * bf_hi(z.y));
      w.z = cvt_pk_bf16(bf_lo(v.z) * bf_lo(z.z), bf_hi(v.z) * bf_hi(z.z)); w.w = cvt_pk_bf16(bf_lo(v.w) * bf_lo(z.w), bf_hi(v.w) * bf_hi(z.w));
      *(u32x4*)(Yw + (long)i * 4 * DM) = w; } }
  __syncthreads();
#undef TROW
#undef SLOAD
#undef SWRITE
#undef SWAIT
#undef RESC
#undef MASKT
}
}

constexpr size_t MiB = 1u << 20;
constexpr size_t WS_MODP = 0;
constexpr size_t WS_MOD = 8 * MiB;
constexpr size_t WS_ROPE = 9 * MiB;
constexpr size_t WS_BAR = 9 * MiB + 512 * 1024;
constexpr size_t WS_W0IN = 10 * MiB;
constexpr size_t WS_W0OUT = 30 * MiB;
constexpr size_t WS_W1IN = 38 * MiB;
constexpr size_t WS_WPOOL = 54 * MiB;
constexpr size_t WS_W1OUT = 56 * MiB;
constexpr size_t WS_H = 64 * MiB;
constexpr size_t WS_P = 196 * MiB;
constexpr size_t WS_Y = 524 * MiB;
constexpr size_t WS_T = 652 * MiB;
constexpr size_t WS_END = 780 * MiB;
constexpr int LDS_BYTES = 147456, MISC_OFF = 131072 + 320;
#ifndef ATT_SEL
#define ATT_SEL 3
#endif

#define XB_TMO      128
#define XB_XCNT(j)  (256  + 64 * (j))
#define XB_XSUB(j)  (1280 + 64 * (j))
#define XB_XGEN(j)  (2304 + 64 * (j))
#define XB_TOP      3328
#define XB_TOPGEN   3392
#define XCD_BAR_WORDS 3456
#define XB_SPIN_CAP (1u << 18)

__device__ __forceinline__ unsigned xb_ld(unsigned* p)              { return __hip_atomic_load(p, __ATOMIC_RELAXED, __HIP_MEMORY_SCOPE_AGENT); }
__device__ __forceinline__ unsigned xb_add(unsigned* p, unsigned v) { return __hip_atomic_fetch_add(p, v, __ATOMIC_RELAXED, __HIP_MEMORY_SCOPE_AGENT); }
__device__ __forceinline__ unsigned xb_xcc_id() { return (unsigned)__builtin_amdgcn_s_getreg((3 << 11) | 20) & 0xFu; }
#define XB_SPIN(cond, bar) do { unsigned _sp = 0; while (cond) { __builtin_amdgcn_s_sleep(1); \
    if ((++_sp & 255u) == 0u) { if (xb_ld(&(bar)[XB_TMO])) break; if (_sp > XB_SPIN_CAP) { atomicAdd(&(bar)[XB_TMO], 1u); break; } } } } while (0)

struct XcdBarrier {
    unsigned* bar; unsigned x;
    volatile LAS unsigned* st;
};

__device__ __forceinline__ XcdBarrier xcd_barrier_post(unsigned* bar, volatile LAS unsigned* st) {
    XcdBarrier b; b.bar = bar; b.x = xb_xcc_id(); b.st = st;
    if (threadIdx.x == 0) (void)xb_add(&bar[XB_XCNT(b.x)], 1u);
    return b;
}
__device__ __forceinline__ void xcd_barrier_complete(unsigned* bar, unsigned x, unsigned& nloc, unsigned& nx) {
    const unsigned G = gridDim.x * gridDim.y * gridDim.z;
    unsigned sum, cnt, mine, sp = 0u;
    for (;;) {
        sum = 0u; cnt = 0u; mine = 0u;
#pragma unroll
        for (unsigned j = 0; j < 16; ++j) { const unsigned c = xb_ld(&bar[XB_XCNT(j)]); sum += c; cnt += (c > 0u) ? 1u : 0u; mine = (j == x) ? c : mine; }
        if (sum == G) break;
        __builtin_amdgcn_s_sleep(1);
        if ((++sp & 255u) == 0u) { if (xb_ld(&bar[XB_TMO])) break; if (sp > XB_SPIN_CAP) { atomicAdd(&bar[XB_TMO], 1u); break; } }
    }
    nloc = mine > 0u ? mine : 1u; nx = cnt > 0u ? cnt : 1u;
}

__device__ __forceinline__ void xcd_barrier(const XcdBarrier& b) {
    asm volatile("s_waitcnt vmcnt(0)" ::: "memory");
    __syncthreads();
    if (threadIdx.x == 0) {
        unsigned* bar = b.bar;
        __builtin_amdgcn_s_waitcnt(0);
        unsigned nloc = b.st[0], nx = b.st[1];
        if (nloc == 0u) { xcd_barrier_complete(bar, b.x, nloc, nx); b.st[0] = nloc; b.st[1] = nx; }
        const unsigned old = xb_add(&bar[XB_XSUB(b.x)], 1u);
        const unsigned gen = old / nloc;
        if (old + 1u == (gen + 1u) * nloc) {
            __builtin_amdgcn_fence(__ATOMIC_RELEASE, "agent");
            asm volatile("s_waitcnt vmcnt(0)" ::: "memory");
            const unsigned og = xb_add(&bar[XB_TOP], 1u);
            const unsigned tg = og / nx;
            if (og + 1u == (tg + 1u) * nx) xb_add(&bar[XB_TOPGEN], 1u);
            else XB_SPIN(xb_ld(&bar[XB_TOPGEN]) == tg, bar);
            __builtin_amdgcn_fence(__ATOMIC_ACQUIRE, "agent");
            xb_add(&bar[XB_XGEN(b.x)], 1u);
            asm volatile("s_waitcnt vmcnt(0)" ::: "memory");
        } else {
            XB_SPIN(xb_ld(&bar[XB_XGEN(b.x)]) == gen, bar);
            __builtin_amdgcn_fence(__ATOMIC_ACQUIRE, "agent");
            asm volatile("s_waitcnt vmcnt(0)" ::: "memory");
        }
    }
    __syncthreads();
}

struct Args { const float* in[21]; float* out; unsigned char* ws; double cs1[32], sn1[32]; int ph_lo, ph_hi; };

__device__ __forceinline__ float wave_sum(float v) {
#pragma unroll
    for (int o = 1; o < 64; o <<= 1) v += __shfl_xor(v, o);
    return v;
}
__device__ __forceinline__ unsigned f2bf(float f) { unsigned u = __builtin_bit_cast(unsigned, f); return (u + 0x7fffu + ((u >> 16) & 1u)) >> 16; }
__device__ __forceinline__ unsigned pk2(float lo, float hi) { return f2bf(lo) | (f2bf(hi) << 16); }

__device__ __forceinline__ void transpose_item(const float* W, int K, int N, bf16_t* WT, int row_off, LAS float* scr, int item, int lane) {
    const int nblk = N / 32, kb = item / nblk, nb = item % nblk, k0 = 64 * kb, n0 = 32 * nb;
#pragma unroll 8
    for (int i = 0; i < 32; ++i) { const int kk = 2 * i + (lane >> 5); scr[kk * 33 + (lane & 31)] = W[(size_t)(k0 + kk) * N + n0 + (lane & 31)]; }
    asm volatile("s_waitcnt lgkmcnt(0)" ::: "memory");
    const int c = lane & 7;
#pragma unroll
    for (int j = 0; j < 4; ++j) { const int n = (lane >> 3) + 8 * j; const LAS float* s = scr + (8 * c) * 33 + n;
        u32x4 o; o.x = pk2(s[0 * 33], s[1 * 33]); o.y = pk2(s[2 * 33], s[3 * 33]); o.z = pk2(s[4 * 33], s[5 * 33]); o.w = pk2(s[6 * 33], s[7 * 33]);
        *(u32x4*)(WT + (size_t)(row_off + n0 + n) * K + k0 + 8 * c) = o; }
    asm volatile("s_waitcnt lgkmcnt(0)" ::: "memory");
}

__device__ __forceinline__ void prenorm_row(const float* xrow, const float* g, const float* shift, const float* scale, bf16_t* orow, int lane) {
    f32x4 v[8]; float s = 0.f;
#pragma unroll
    for (int j = 0; j < 8; ++j) { v[j] = *(const f32x4*)(xrow + 4 * lane + 256 * j); s += (v[j].x * v[j].x + v[j].y * v[j].y) + (v[j].z * v[j].z + v[j].w * v[j].w); }
    const float rstd = 1.0f / sqrtf(wave_sum(s) * (1.f / DM) + EPS);
#pragma unroll
    for (int j = 0; j < 8; ++j) { const int c = 4 * lane + 256 * j; const f32x4 gg = *(const f32x4*)(g + c), sh = *(const f32x4*)(shift + c), sc = *(const f32x4*)(scale + c);
        const f32x4 y = v[j] * rstd * gg * (sc + 1.0f) + sh;
        u32x2 w; w.x = cvt_pk_bf16(y.x, y.y); w.y = cvt_pk_bf16(y.z, y.w); *(u32x2*)(orow + c) = w; }
}
template <bool NEXT>
__device__ __forceinline__ void postnorm_row(const bf16_t* trow, const float* xres, const float* post_g, const float* gate, float* xout,
                                             const float* g2, const float* shift2, const float* scale2, bf16_t* hrow, int lane) {
    f32x4 t[8]; float s = 0.f;
#pragma unroll
    for (int j = 0; j < 8; ++j) { const u32x2 w = *(const u32x2*)(trow + 4 * lane + 256 * j); t[j] = (f32x4){bf_lo(w.x), bf_hi(w.x), bf_lo(w.y), bf_hi(w.y)};
        s += (t[j].x * t[j].x + t[j].y * t[j].y) + (t[j].z * t[j].z + t[j].w * t[j].w); }
    const float rstd = 1.0f / sqrtf(wave_sum(s) * (1.f / DM) + EPS);
    float s2 = 0.f;
#pragma unroll
    for (int j = 0; j < 8; ++j) { const int c = 4 * lane + 256 * j; const f32x4 pg = *(const f32x4*)(post_g + c), ga = *(const f32x4*)(gate + c), xr = *(const f32x4*)(xres + c);
        t[j] = xr + ga * (t[j] * rstd * pg); *(f32x4*)(xout + c) = t[j];
        s2 += (t[j].x * t[j].x + t[j].y * t[j].y) + (t[j].z * t[j].z + t[j].w * t[j].w); }
    if (NEXT) {
        const float rstd2 = 1.0f / sqrtf(wave_sum(s2) * (1.f / DM) + EPS);
#pragma unroll
        for (int j = 0; j < 8; ++j) { const int c = 4 * lane + 256 * j; const f32x4 gg = *(const f32x4*)(g2 + c), sh = *(const f32x4*)(shift2 + c), sc = *(const f32x4*)(scale2 + c);
            const f32x4 y = t[j] * rstd2 * gg * (sc + 1.0f) + sh;
            u32x2 w; w.x = cvt_pk_bf16(y.x, y.y); w.y = cvt_pk_bf16(y.z, y.w); *(u32x2*)(hrow + c) = w; }
    }
}

template <int H>
__device__ __forceinline__ void pool_chunk(const bf16_t* __restrict__ Pp, bf16_t* __restrict__ Hp, size_t base, int t0, int cg8) {
    constexpr int NR = 8 + 2 * H - 1;
    u32x4 w[NR];
#pragma unroll
    for (int i = 0; i < NR; ++i) { const int t = t0 - H + i; w[i] = (u32x4){0u, 0u, 0u, 0u}; if (t >= 0 && t < SEQ) w[i] = *(const u32x4*)(Pp + (base + t) * ODD_IN + cg8); }
    float S[8] = {0.f, 0.f, 0.f, 0.f, 0.f, 0.f, 0.f, 0.f};
#pragma unroll
    for (int i = 0; i < 2 * H; ++i) { S[0] += bf_lo(w[i].x); S[1] += bf_hi(w[i].x); S[2] += bf_lo(w[i].y); S[3] += bf_hi(w[i].y); S[4] += bf_lo(w[i].z); S[5] += bf_hi(w[i].z); S[6] += bf_lo(w[i].w); S[7] += bf_hi(w[i].w); }
#pragma unroll
    for (int r = 0; r < 8; ++r) { const int t = t0 + r; const int tlo = (t - H) > 0 ? (t - H) : 0, thi = (t + H) < SEQ ? (t + H) : SEQ; const float inv = 1.0f / (float)(thi - tlo);
        const u32x4 ow = w[r + H];
        u32x4 o; o.x = cvt_pk_bf16(S[0] * inv - bf_lo(ow.x), S[1] * inv - bf_hi(ow.x)); o.y = cvt_pk_bf16(S[2] * inv - bf_lo(ow.y), S[3] * inv - bf_hi(ow.y));
        o.z = cvt_pk_bf16(S[4] * inv - bf_lo(ow.z), S[5] * inv - bf_hi(ow.z)); o.w = cvt_pk_bf16(S[6] * inv - bf_lo(ow.w), S[7] * inv - bf_hi(ow.w));
        *(u32x4*)(Hp + (base + t) * DM + cg8) = o;
        if (r < 7) { const u32x4 a = w[r + 2 * H], d = w[r];
            S[0] += bf_lo(a.x) - bf_lo(d.x); S[1] += bf_hi(a.x) - bf_hi(d.x); S[2] += bf_lo(a.y) - bf_lo(d.y); S[3] += bf_hi(a.y) - bf_hi(d.y);
            S[4] += bf_lo(a.z) - bf_lo(d.z); S[5] += bf_hi(a.z) - bf_hi(d.z); S[6] += bf_lo(a.w) - bf_lo(d.w); S[7] += bf_hi(a.w) - bf_hi(d.w); } }
}

__global__ void __launch_bounds__(512, 2) mk_fwd(Args args) {
    extern __shared__ __attribute__((aligned(16))) unsigned char lds[];
    cg::grid_group grid = cg::this_grid();
    const int tid = threadIdx.x, lane = tid & 63, wave = __builtin_amdgcn_readfirstlane(tid >> 6);
    const int G = gridDim.x, bx = blockIdx.x;
    const int vcu = (G % 8 == 0) ? (bx % 8) * (G / 8) + bx / 8 : bx;
    const int gw = vcu * 8 + wave, NGW = G * 8;
    unsigned char* ws = args.ws;
    const float* x = args.in[0]; const float* cvec = args.in[1]; const float* ctx = args.in[2]; const float* c_ctx = args.in[3];
    float* modp = (float*)(ws + WS_MODP); float* mod = (float*)(ws + WS_MOD);
    float* rowtab = (float*)(ws + WS_ROPE); float* coltab = rowtab + 256 * 32 * 2;
    bf16_t* W0in = (bf16_t*)(ws + WS_W0IN); bf16_t* W0out = (bf16_t*)(ws + WS_W0OUT); bf16_t* W1in = (bf16_t*)(ws + WS_W1IN);
    bf16_t* Wpool = (bf16_t*)(ws + WS_WPOOL); bf16_t* W1out = (bf16_t*)(ws + WS_W1OUT);
    bf16_t* Hb = (bf16_t*)(ws + WS_H); bf16_t* Pb = (bf16_t*)(ws + WS_P); bf16_t* Yb = (bf16_t*)(ws + WS_Y); bf16_t* Tb = (bf16_t*)(ws + WS_T);
    float* out = args.out;
    const int lo = args.ph_lo, hi = args.ph_hi;
    volatile LAS unsigned* MISC = (volatile LAS unsigned*)((LAS unsigned char*)lds + MISC_OFF);
    if (tid < 32) MISC[tid] = 0u;
    __syncthreads();
    if (lo < 0) { __threadfence(); grid.sync(); __threadfence(); }
    XcdBarrier bar = xcd_barrier_post((unsigned*)(ws + WS_BAR), MISC + 8);
#ifndef MK_MASK
#define MK_MASK 0x1fff
#endif
#define IN(k) (((MK_MASK >> (k)) & 1) && lo <= (k) && (k) < hi)
#ifndef MK_DUP
#define MK_DUP 0
#endif
#define REP(k) for (int rep_ = 0; rep_ < (((MK_DUP >> (k)) & 1) ? 2 : 1); ++rep_)
#define SEAM(k) do { if (IN(k) && IN((k) + 1)) xcd_barrier(bar); } while (0)

    if (IN(0)) REP(0) {
        {
            LAS float* sl = (LAS float*)lds;
            for (int i = tid; i < 3 * DM; i += 512) { const float v = i < 2 * DM ? cvec[i] : c_ctx[i - 2 * DM]; sl[i] = silu_f(v); }
            __syncthreads();
            for (int it = bx; it < 2 * 12 * 32; it += G) {
                const int l = it / 384, cb = (it % 384) / 32, kc = it % 32; const float* W = args.in[l ? 13 : 4]; const int j = cb * 512 + tid;
                float s0 = 0.f, s1 = 0.f, s2 = 0.f;
#pragma unroll 8
                for (int k = kc * 64; k < kc * 64 + 64; ++k) { const float w = W[(size_t)k * (3 * DM) + j]; s0 += sl[k] * w; s1 += sl[DM + k] * w; s2 += sl[2 * DM + k] * w; }
                float* pp = modp + ((size_t)(l * 32 + kc) * 3) * (3 * DM) + j; pp[0] = s0; pp[3 * DM] = s1; pp[2 * 3 * DM] = s2;
            }
            __syncthreads();
        }
        {
            LAS float* scr = (LAS float*)(lds + wave * 16384);
            constexpr int I0 = (DM / 64) * (EVEN_IN / 32), I1 = (DM / 64) * (DM / 32), I2 = (DM / 64) * (ODD_IN / 32), I3 = 4 * (512 / 64) * (512 / 32), I4 = I1;
            for (int it = gw; it < I0 + I1 + I2 + I3 + I4; it += NGW) {
                int r = it;
                if (r < I0) { transpose_item(args.in[8], DM, EVEN_IN, W0in, 0, scr, r, lane); continue; } r -= I0;
                if (r < I1) { transpose_item(args.in[12], DM, DM, W0out, 0, scr, r, lane); continue; } r -= I1;
                if (r < I2) { transpose_item(args.in[17], DM, ODD_IN, W1in, 0, scr, r, lane); continue; } r -= I2;
                if (r < I3) { const int g = r / 128; transpose_item(args.in[18] + (size_t)g * 512 * 512, 512, 512, Wpool, g * 512, scr, r % 128, lane); continue; } r -= I3;
                transpose_item(args.in[20], DM, DM, W1out, 0, scr, r, lane);
            }
        }
        if (bx == 0 && tid < 32) {
            const double c1 = args.cs1[tid], s1 = args.sn1[tid]; double c = 1.0, s = 0.0;
            for (int n = 0; n < 256; ++n) { rowtab[(n * 32 + tid) * 2] = (float)c; rowtab[(n * 32 + tid) * 2 + 1] = (float)s;
                if (n < 64) { coltab[(n * 32 + tid) * 2] = (float)c; coltab[(n * 32 + tid) * 2 + 1] = (float)s; }
                const double cn = c * c1 - s * s1, sn = s * c1 + c * s1; c = cn; s = sn; }
        }
    }
    SEAM(0);
    if (IN(1)) {
        for (int i = bx * 512 + tid; i < 2 * 3 * 3 * DM; i += G * 512) {
            const int l = i / (9 * DM), v = (i / (3 * DM)) % 3, j = i % (3 * DM); float s = args.in[l ? 14 : 5][j];
            for (int kc = 0; kc < 32; ++kc) s += modp[((size_t)(l * 32 + kc) * 3 + v) * (3 * DM) + j];
            mod[i] = s;
        }
    }
    SEAM(1);
    if (IN(2)) REP(2) {
        for (int m = gw; m < MALL; m += NGW) {
            const float* xr; int v;
            if (m < MLAT) { xr = x + (size_t)m * DM; v = m / SEQ; } else { xr = ctx + (size_t)(m - MLAT) * DM; v = 2; }
            const float* mv = mod + (size_t)v * 3 * DM;
            prenorm_row(xr, args.in[6], mv, mv + DM, Hb + (size_t)m * DM, lane);
        }
    }
    SEAM(2);
    if (IN(3)) REP(3) {
        pg8::Gemm g{Hb, W0in, MALL, EVEN_IN, DM, DM, DM, 1 << 20}; pg8::StaticOrder S; S.init(MALL, EVEN_IN, G, bx);
        pg8::EpiMk E{Pb, EVEN_IN, COL_Z, nullptr, nullptr, 0};
        pg8::gemm_phase<pg8::EpiMk, pg8::StaticOrder, true, true>((LAS unsigned char*)lds, g, S, E);
    }
    SEAM(3);
    if (IN(4)) {
        const float* qn = args.in[9]; const float* kn = args.in[10];
        const int sub = lane & 15, e0 = sub * 8, i0 = (sub & 7) * 8, hq = lane >> 4; const bool upper = sub >= 8;
        float gq[8], gk[8];
#pragma unroll
        for (int e = 0; e < 8; ++e) { gq[e] = qn[e0 + e]; gk[e] = kn[e0 + e]; }
        for (int m = gw; m < MALL; m += NGW) {
            const bool isctx = m >= MLAT;
            bf16_t* prow_ = Pb + (size_t)m * EVEN_IN + hq * HD + e0;
            u32x4 w[6];
#pragma unroll
            for (int hg = 0; hg < 6; ++hg) w[hg] = *(const u32x4*)(prow_ + hg * 4 * HD);
            const int t = m & (SEQ - 1); const int prow = t >> 6, pcol = t & 63;
            const float* tab = (i0 < 32) ? (rowtab + (prow * 32 + i0) * 2) : (coltab + (pcol * 32 + (i0 - 32)) * 2);
            f32x4 tb[4];
#pragma unroll
            for (int q = 0; q < 4; ++q) tb[q] = *(const f32x4*)(tab + 4 * q);
#pragma unroll
            for (int hg = 0; hg < 6; ++hg) {
                const int hd = hg * 4 + hq;
                const bool is_qa = hg < 2, is_ka = (hg == 4 && hq < 2), is_v = (hg >= 4 && hq >= 2);
                const bool do_norm = is_qa || is_ka, do_rope = !is_v && !isctx;
                float v[8] = {bf_lo(w[hg].x), bf_hi(w[hg].x), bf_lo(w[hg].y), bf_hi(w[hg].y), bf_lo(w[hg].z), bf_hi(w[hg].z), bf_lo(w[hg].w), bf_hi(w[hg].w)};
                if (hg < 2 || hg == 4) {
                    float ss = 0.f;
#pragma unroll
                    for (int e = 0; e < 8; ++e) ss += v[e] * v[e];
                    ss += __shfl_xor(ss, 1); ss += __shfl_xor(ss, 2); ss += __shfl_xor(ss, 4); ss += __shfl_xor(ss, 8);
                    if (do_norm) { const float rstd = 1.0f / sqrtf(ss * (1.f / HD) + EPS);
#pragma unroll
                        for (int e = 0; e < 8; ++e) v[e] = v[e] * rstd * (is_qa ? gq[e] : gk[e]); }
                }
                float r[8];
#pragma unroll
                for (int e = 0; e < 8; ++e) { const float oth = __shfl_xor(v[e], 8); float cs = 1.f, sn = 0.f; if (do_rope) { cs = tb[e >> 1][(e & 1) * 2]; sn = tb[e >> 1][(e & 1) * 2 + 1]; }
                    r[e] = upper ? (v[e] * cs + oth * sn) : (v[e] * cs - oth * sn); }
                (void)hd;
                if (!is_v && (!isctx || is_ka)) { u32x4 o; o.x = cvt_pk_bf16(r[0], r[1]); o.y = cvt_pk_bf16(r[2], r[3]); o.z = cvt_pk_bf16(r[4], r[5]); o.w = cvt_pk_bf16(r[6], r[7]); *(u32x4*)(prow_ + hg * 4 * HD) = o; }
            }
        }
    }
    SEAM(4);
    if (IN(5)) REP(5) {
        const float* sink = args.in[11];
#define ATT_UNIT_SETUP const int uu = u & 1023; const int combo = (uu & 255) >> 6, qb = uu & 63, gq = uu >> 8;   \
            const int b = combo >> 1, kv = combo & 1; const long lat0 = (long)b * SEQ, ctx0 = (long)MLAT + (long)b * CTX; const int q0 = qb * 256; \
            const bf16_t* Qp = Pb + (size_t)(lat0 + q0) * EVEN_IN + COL_Q + head * HD; const bf16_t* Zp = Pb + (size_t)(lat0 + q0) * EVEN_IN + COL_Z + head * HD; \
            bf16_t* Yp = Yb + (size_t)(lat0 + q0) * DM + head * HD;
        if (ATT_SEL & 1) for (int u = vcu; u < 1024; u += G) {
            const int head = (((u & 255) >> 6) & 1) * 4 + (u >> 8);
            ATT_UNIT_SETUP
            att::attn_unit<false>(Qp, Pb + COL_KA + kv * HD, Pb + COL_VA + kv * HD, Zp, Yp, lat0, ctx0, q0, 0.f, (char*)lds);
        }
        if (ATT_SEL & 2) {
            unsigned* ctr = (unsigned*)(args.ws + WS_BAR) + 3584;
            for (;;) {
                __syncthreads();
                if (tid == 0) MISC[16] = __hip_atomic_fetch_add(ctr, 1u, __ATOMIC_RELAXED, __HIP_MEMORY_SCOPE_AGENT);
                __syncthreads();
                const int ub = (int)MISC[16];
                if (ub >= 1024) break;
                const int u = 1024 + ub;
                const int head = 8 + (((u & 255) >> 6) & 1) * 4 + ((u & 1023) >> 8);
                ATT_UNIT_SETUP
                att::attn_unit<true>(Qp, Pb + COL_KB + kv * HD, Pb + COL_VB + kv * HD, Zp, Yp, lat0, ctx0, q0, sink[kv * 4 + gq], (char*)lds);
            }
        }
#undef ATT_UNIT_SETUP
    }
    SEAM(5);
    if (IN(6)) REP(6) {
        pg8::Gemm g{Yb, W0out, MLAT, DM, DM, DM, DM, 1 << 20}; pg8::StaticOrder S; S.init(MLAT, DM, G, bx);
        pg8::EpiMk E{Tb, DM, 1 << 30, nullptr, nullptr, 0};
        pg8::gemm_phase<pg8::EpiMk, pg8::StaticOrder, true, true>((LAS unsigned char*)lds, g, S, E);
    }
    SEAM(6);
    if (IN(7)) REP(7) {
        for (int m = gw; m < MLAT; m += NGW) {
            const int b = m / SEQ; const float* m0 = mod + (size_t)b * 3 * DM; const float* m1 = mod + (size_t)(3 + b) * 3 * DM;
            postnorm_row<true>(Tb + (size_t)m * DM, x + (size_t)m * DM, args.in[7], m0 + 2 * DM, out + (size_t)m * DM, args.in[15], m1, m1 + DM, Hb + (size_t)m * DM, lane);
        }
    }
    SEAM(7);
    if (IN(8)) REP(8) {
        pg8::Gemm g{Hb, W1in, MLAT, ODD_IN, DM, DM, DM, 1 << 20}; pg8::StaticOrder S; S.init(MLAT, ODD_IN, G, bx);
        pg8::EpiMk E{Pb, ODD_IN, DM, nullptr, nullptr, 0};
        pg8::gemm_phase<pg8::EpiMk, pg8::StaticOrder, true, true>((LAS unsigned char*)lds, g, S, E);
    }
    SEAM(8);
    if (IN(9)) REP(9) {
        const int cg8 = (tid & 255) * 8, g = __builtin_amdgcn_readfirstlane(cg8 >> 9);
        for (int ch = bx; ch < MLAT / 16; ch += G) {
            const int m0 = ch * 16 + (tid >> 8) * 8, t0 = m0 & (SEQ - 1); const size_t base = (size_t)(m0 - t0);
            if (g == 0) pool_chunk<1>(Pb, Hb, base, t0, cg8); else if (g == 1) pool_chunk<2>(Pb, Hb, base, t0, cg8);
            else if (g == 2) pool_chunk<4>(Pb, Hb, base, t0, cg8); else pool_chunk<8>(Pb, Hb, base, t0, cg8);
        }
    }
    SEAM(9);
    if (IN(10)) REP(10) {
        pg8::Gemm g{Hb, Wpool, MLAT, DM, 512, DM, 512, 2}; pg8::StaticOrder S; S.init(MLAT, DM, G, bx);
        pg8::EpiMk E{Yb, DM, 1 << 30, args.in[19], Pb + DM, ODD_IN};
        pg8::gemm_phase<pg8::EpiMk, pg8::StaticOrder, true, true>((LAS unsigned char*)lds, g, S, E);
    }
    SEAM(10);
    if (IN(11)) REP(11) {
        pg8::Gemm g{Yb, W1out, MLAT, DM, DM, DM, DM, 1 << 20}; pg8::StaticOrder S; S.init(MLAT, DM, G, bx);
        pg8::EpiMk E{Tb, DM, 1 << 30, nullptr, nullptr, 0};
        pg8::gemm_phase<pg8::EpiMk, pg8::StaticOrder, true, true>((LAS unsigned char*)lds, g, S, E);
    }
    SEAM(11);
    if (IN(12)) {
        for (int m = gw; m < MLAT; m += NGW) {
            const int b = m / SEQ; const float* m1 = mod + (size_t)(3 + b) * 3 * DM;
            postnorm_row<false>(Tb + (size_t)m * DM, out + (size_t)m * DM, args.in[16], m1 + 2 * DM, out + (size_t)m * DM, nullptr, nullptr, nullptr, nullptr, lane);
        }
    }
#ifdef MK_XSYNC
    for (int i = 0; i < MK_XSYNC; ++i) xcd_barrier(bar);
#endif
#undef IN
#undef SEAM
}

constexpr int N_PHASES = 13;
#ifndef MK_PER_PHASE
#define MK_PER_PHASE 0
#endif
extern "C" void kernel_launch(void* const* d_in, const int* in_sizes, int n_in, void* d_out, int out_size, void* d_ws, size_t ws_size, hipStream_t stream) {
    static int grid = 0;
    if (grid == 0) {
        if (n_in != 21 || out_size != MLAT * DM || ws_size < WS_END) { fprintf(stderr, "kernel_launch: unexpected shapes (n_in %d out %d ws %zu)\n", n_in, out_size, ws_size); grid = -1; return; }
        int dev = 0, cus = 0, per_cu = 0;
        hipGetDevice(&dev); hipDeviceGetAttribute(&cus, hipDeviceAttributeMultiprocessorCount, dev);
        if (hipFuncSetAttribute((const void*)mk_fwd, hipFuncAttributeMaxDynamicSharedMemorySize, LDS_BYTES) != hipSuccess) { fprintf(stderr, "kernel_launch: hipFuncSetAttribute failed\n"); grid = -1; return; }
        if (hipOccupancyMaxActiveBlocksPerMultiprocessor(&per_cu, (const void*)mk_fwd, 512, LDS_BYTES) != hipSuccess || per_cu < 1) per_cu = 1;
        (void)hipGetLastError();
        grid = cus * per_cu;
    }
    if (grid < 0) return;
    (void)hipMemsetAsync((char*)d_ws + WS_BAR, 0, 4096 * 4, stream);
    Args a{};
    for (int i = 0; i < 21; ++i) a.in[i] = (const float*)d_in[i];
    a.out = (float*)d_out; a.ws = (unsigned char*)d_ws;
    for (int f = 0; f < 32; ++f) { const double inv = pow(10000.0, -(double)f / 32.0); a.cs1[f] = cos(inv); a.sn1[f] = sin(inv); }
#if MK_PER_PHASE
    for (int p = 0; p < N_PHASES; ++p) { a.ph_lo = p; a.ph_hi = p + 1; hipLaunchKernelGGL(mk_fwd, dim3(grid), dim3(512), LDS_BYTES, stream, a); }
#else
    a.ph_lo = 0; a.ph_hi = N_PHASES;
    void* kargs[] = {&a};
    hipError_t e = hipLaunchCooperativeKernel((const void*)mk_fwd, dim3(grid), dim3(512), kargs, LDS_BYTES, stream);
    if (e != hipSuccess) fprintf(stderr, "kernel_launch: cooperative launch failed: %s (grid %d)\n", hipGetErrorString(e), grid);
#endif
}
```

```cpp
#include <hip/hip_runtime.h>
#include <hip/hip_cooperative_groups.h>
#include <cstdio>
#include <cstdint>
#include <cmath>
namespace cg = cooperative_groups;

#define LAS __attribute__((address_space(3)))
typedef unsigned short bf16_t;
typedef short bf16x8 __attribute__((ext_vector_type(8)));
typedef short s16x4 __attribute__((ext_vector_type(4)));
typedef float f32x4 __attribute__((ext_vector_type(4)));
typedef float f32x16 __attribute__((ext_vector_type(16)));
typedef unsigned u32x4 __attribute__((ext_vector_type(4)));
typedef unsigned u32x2 __attribute__((ext_vector_type(2)));

__device__ __forceinline__ unsigned cvt_pk_bf16(float lo, float hi) { unsigned r; asm volatile("v_cvt_pk_bf16_f32 %0, %1, %2" : "=v"(r) : "v"(lo), "v"(hi)); return r; }
__device__ __forceinline__ float bf_lo(unsigned w) { return __uint_as_float(w << 16); }
__device__ __forceinline__ float bf_hi(unsigned w) { return __uint_as_float(w & 0xffff0000u); }
__device__ __forceinline__ float bf2f(bf16_t h) { return __uint_as_float(((unsigned)h) << 16); }
__device__ __forceinline__ float silu_f(float v) { return v * __builtin_amdgcn_rcpf(1.f + __builtin_amdgcn_exp2f(-v * 1.4426950408889634f)); }

constexpr int DM = 2048, NB = 2, SEQ = 16384, CTX = 256, HD = 128;
constexpr int MLAT = NB * SEQ;
constexpr int MALL = MLAT + NB * CTX;
constexpr int EVEN_IN = 5120, ODD_IN = 4096;
constexpr int COL_Q = 0, COL_KA = 2048, COL_VA = 2304, COL_KB = 2560, COL_VB = 2816, COL_Z = 3072;
constexpr float EPS = 1e-6f;

namespace pg8 {
constexpr int BM = 256, BK = 64, HALF = 128, HTB = HALF * BK * 2, STAGE_BYTES = 8 * HTB, NXCD = 8, WGM = 8;
__host__ __device__ __forceinline__ int lds_byte(int r, int c) { const int st = (r >> 4) * 2 + (c >> 5), rr = r & 15, cc = c & 31, ob = rr * 64 + cc * 2; return st * 1024 + (ob ^ (((ob >> 9) & 1) << 5)); }
__host__ __device__ __forceinline__ void stage_rc(int b, int& R, int& C) { const int st = b / 1024, sb = b % 1024, swz = sb ^ (((sb >> 9) & 1) << 5); R = (st >> 1) * 16 + swz / 64; C = (st & 1) * 32 + (swz % 64) / 2; }
__host__ __device__ __forceinline__ int perm32(int rho) { const int n = rho >> 4, i = rho & 15; return 8 * (i >> 2) + 4 * n + (i & 3); }

struct Unit { int pm, pn; };
struct Gemm { const bf16_t* A; const bf16_t* Bt; int M, N, K, lda, ldb, gdiv; };

struct StaticOrder {
    int nM, nN, nwg, G, c;
    __host__ __device__ void init(int M, int N, int G_, int c_) { nM = M / BM; nN = N / BM; nwg = nM * nN; G = G_; c = c_; }
    __host__ __device__ bool next(int i, Unit& u) const {
        const long L = (long)i * G + c; if (L >= nwg) return false;
        int wgid = (int)L; { const int q = nwg / NXCD, r = nwg % NXCD, xcd = wgid % NXCD, off = wgid / NXCD; wgid = (xcd < r ? xcd * (q + 1) : r * (q + 1) + (xcd - r) * q) + off; }
        const int nig = WGM * nN, gid = wgid / nig, fm = gid * WGM, gsz = (nM - fm) < WGM ? (nM - fm) : WGM;
        u.pm = fm + ((wgid % nig) % gsz); u.pn = (wgid % nig) / gsz; return true;
    }
    __device__ __forceinline__ void a_ready(const Unit&) const {}
    __device__ __forceinline__ void done(const Unit&) const {}
};

struct EpiMk {
    static constexpr bool PERM = true, AFTER_DRAIN = false;
    bf16_t* O; int ldc; int silu_from; const float* cscale; const bf16_t* mul; int ldmul;
    __device__ __forceinline__ void operator()(const f32x4 (&acc)[2][2][4][2], const Unit& u, int wr, int wc, int fr, int fq) const {
        const int row0 = u.pm * BM + wr * 64 + fr; const int colt = u.pn * BM; const int col0 = colt + wc * 32 + 8 * fq;
        const bool dosilu = colt >= silu_from;
        f32x4 cs[2][2];
#pragma unroll
        for (int bj = 0; bj < 2; ++bj)
#pragma unroll
            for (int n = 0; n < 2; ++n) cs[bj][n] = cscale ? *(const f32x4*)(cscale + col0 + bj * HALF + 4 * n) : (f32x4){1.f, 1.f, 1.f, 1.f};
#pragma unroll
        for (int ai = 0; ai < 2; ++ai)
#pragma unroll
            for (int m = 0; m < 4; ++m) { const size_t row = (size_t)(row0 + ai * HALF + m * 16); bf16_t* rowp = O + row * ldc + col0;
#pragma unroll
                for (int bj = 0; bj < 2; ++bj) { f32x4 v0 = acc[ai][bj][m][0] * cs[bj][0], v1 = acc[ai][bj][m][1] * cs[bj][1];
                    if (mul) { const u32x4 mv = *(const u32x4*)(mul + row * ldmul + col0 + bj * HALF);
                        v0[0] *= bf_lo(mv.x); v0[1] *= bf_hi(mv.x); v0[2] *= bf_lo(mv.y); v0[3] *= bf_hi(mv.y); v1[0] *= bf_lo(mv.z); v1[1] *= bf_hi(mv.z); v1[2] *= bf_lo(mv.w); v1[3] *= bf_hi(mv.w); }
                    if (dosilu) {
#pragma unroll
                        for (int e = 0; e < 4; ++e) { v0[e] = silu_f(v0[e]); v1[e] = silu_f(v1[e]); } }
                    u32x4 w; w.x = cvt_pk_bf16(v0[0], v0[1]); w.y = cvt_pk_bf16(v0[2], v0[3]); w.z = cvt_pk_bf16(v1[0], v1[1]); w.w = cvt_pk_bf16(v1[2], v1[3]);
                    *(u32x4*)(rowp + bj * HALF) = w; } }
    }
};

#define PG8_LAS LAS
template <class Epi, class Sched, bool ALIGN_EPI = false, bool SP2 = false>
__device__ __forceinline__ void gemm_phase(PG8_LAS unsigned char* lds, const Gemm g, const Sched& S, const Epi& E) {
    const int tid = threadIdx.x, wid = __builtin_amdgcn_readfirstlane(tid >> 6), lane = tid & 63, wr = wid >> 2, wc = wid & 3, fr = lane & 15, fq = lane >> 4;
    const int K = g.K, nt = K / BK;
    unsigned voffA[2], voffB[2];
#pragma unroll
    for (int i = 0; i < 2; ++i) { int R, C; stage_rc(tid * 16 + i * 8192, R, C); const int Rb = Epi::PERM ? ((R & ~31) + perm32(R & 31)) : R;
        voffA[i] = (unsigned)(R * g.lda + C) * 2u; voffB[i] = (unsigned)(Rb * g.ldb + C) * 2u; }
    const size_t kstep = (size_t)(BK * 2);
    const size_t hstepA = (size_t)HALF * g.lda * 2, hstepB = (size_t)HALF * g.ldb * 2;
    const size_t tstepA = 2 * hstepA, tstepB = 2 * hstepB;
    const unsigned ldsw = (unsigned)wid * 1024u;
    const int aoff = lds_byte(wr * 64 + fr, fq * 8), boff = lds_byte(wc * 32 + fr, fq * 8);
#define PG8_SA(b, h) (((b) * 2 + (h)) * HTB)
#define PG8_SB(b, h) ((4 + (b) * 2 + (h)) * HTB)
#define PG8_STAGE(bufoff, gbase, voff) do { _Pragma("unroll") for (int _i = 0; _i < 2; ++_i) \
        __builtin_amdgcn_global_load_lds((const unsigned*)((const char*)(gbase) + (voff)[_i]), (PG8_LAS unsigned*)(lds + (bufoff) + ldsw + _i * 8192), 16, 0, 0); } while (0)
#define PG8_LDA(dst, b, h) do { _Pragma("unroll") for (int m = 0; m < 4; ++m) _Pragma("unroll") for (int k = 0; k < 2; ++k) dst[m][k] = *(const PG8_LAS bf16x8*)(lds + PG8_SA(b, h) + aoff + m * 2048 + k * 1024); } while (0)
#define PG8_LDB(dst, b, h) do { _Pragma("unroll") for (int n = 0; n < 2; ++n) _Pragma("unroll") for (int k = 0; k < 2; ++k) dst[n][k] = *(const PG8_LAS bf16x8*)(lds + PG8_SB(b, h) + boff + n * 2048 + k * 1024); } while (0)
#define PG8_MMA(ai, bj, At, Bt) do { __builtin_amdgcn_s_setprio(1); _Pragma("unroll") for (int m = 0; m < 4; ++m) _Pragma("unroll") for (int n = 0; n < 2; ++n) _Pragma("unroll") for (int k = 0; k < 2; ++k) \
        acc[ai][bj][m][n] = __builtin_amdgcn_mfma_f32_16x16x32_bf16(Bt[n][k], At[m][k], acc[ai][bj][m][n], 0, 0, 0); __builtin_amdgcn_s_setprio(0); } while (0)
#define PG8_WAIT_V(n) asm volatile("s_waitcnt vmcnt(" #n ")" ::: "memory")
#define PG8_WAIT_L(n) asm volatile("s_waitcnt lgkmcnt(" #n ")" ::: "memory")
#define PG8_BAR __builtin_amdgcn_s_barrier()
#define PG8_SCHED __builtin_amdgcn_sched_barrier(0)
    Unit cur, nxt; int ui = 0;
    if (!S.next(0, cur)) return;
    f32x4 acc[2][2][4][2];
#pragma unroll
    for (int a = 0; a < 2; ++a)
#pragma unroll
        for (int b = 0; b < 2; ++b)
#pragma unroll
            for (int m = 0; m < 4; ++m)
#pragma unroll
                for (int n = 0; n < 2; ++n) acc[a][b][m][n] = (f32x4){0.f, 0.f, 0.f, 0.f};
    bf16x8 At[4][2], B0[2][2], B1[2][2];
    const char* cA = (const char*)g.A + (size_t)cur.pm * tstepA + (size_t)(cur.pn / g.gdiv) * (size_t)K * 2; const char* cB = (const char*)g.Bt + (size_t)cur.pn * tstepB;
    S.a_ready(cur);
    if constexpr (SP2) {
        PG8_STAGE(PG8_SB(0, 0), cB, voffB); PG8_STAGE(PG8_SB(0, 1), cB + hstepB, voffB); PG8_STAGE(PG8_SA(0, 0), cA, voffA); PG8_STAGE(PG8_SA(0, 1), cA + hstepA, voffA);
        if (wr == 1) PG8_BAR;
        PG8_WAIT_V(2); PG8_BAR;
        PG8_STAGE(PG8_SB(1, 0), cB + kstep, voffB); PG8_STAGE(PG8_SA(1, 0), cA + kstep, voffA); PG8_STAGE(PG8_SB(1, 1), cB + hstepB + kstep, voffB);
        PG8_WAIT_V(6); PG8_BAR;
    } else {
        PG8_STAGE(PG8_SB(0, 0), cB, voffB); PG8_STAGE(PG8_SA(0, 0), cA, voffA); PG8_STAGE(PG8_SB(0, 1), cB + hstepB, voffB); PG8_STAGE(PG8_SA(0, 1), cA + hstepA, voffA);
        if (wr == 1) PG8_BAR;
        PG8_WAIT_V(4); PG8_BAR;
        PG8_STAGE(PG8_SB(1, 0), cB + kstep, voffB); PG8_STAGE(PG8_SA(1, 0), cA + kstep, voffA); PG8_STAGE(PG8_SB(1, 1), cB + hstepB + kstep, voffB);
        PG8_WAIT_V(6); PG8_BAR;
    }
    for (;;) {
        const bool has_next = S.next(ui + 1, nxt);
        const char* nA = has_next ? (const char*)g.A + (size_t)nxt.pm * tstepA + (size_t)(nxt.pn / g.gdiv) * (size_t)K * 2 : cA; const char* nB = has_next ? (const char*)g.Bt + (size_t)nxt.pn * tstepB : cB;
        for (int t = 0; t < nt; t += 2) {
            const bool last = (t == nt - 2);
            const char* a1 = cA + (size_t)(t + 1) * kstep;
            const char* a2 = last ? nA : cA + (size_t)(t + 2) * kstep; const char* b2 = last ? nB : cB + (size_t)(t + 2) * kstep;
            const char* a3 = a2 + kstep; const char* b3 = b2 + kstep;
            if (last && has_next) S.a_ready(nxt);
            if constexpr (SP2) {
            PG8_LDB(B0, 0, 0); PG8_LDB(B1, 0, 1); PG8_SCHED; PG8_LDA(At, 0, 0); PG8_STAGE(PG8_SA(1, 1), a1 + hstepA, voffA);
            PG8_WAIT_V(8); PG8_WAIT_L(0); PG8_BAR; PG8_MMA(0, 0, At, B0); PG8_MMA(0, 1, At, B1); PG8_BAR; PG8_SCHED;
            PG8_LDA(At, 0, 1); PG8_STAGE(PG8_SB(0, 0), b2, voffB); PG8_STAGE(PG8_SB(0, 1), b2 + hstepB, voffB); PG8_STAGE(PG8_SA(0, 0), a2, voffA);
            PG8_WAIT_V(8); PG8_WAIT_L(0); PG8_BAR; PG8_MMA(1, 0, At, B0); PG8_MMA(1, 1, At, B1); PG8_BAR; PG8_SCHED;
            PG8_LDB(B0, 1, 0); PG8_LDB(B1, 1, 1); PG8_SCHED; PG8_LDA(At, 1, 0); PG8_STAGE(PG8_SA(0, 1), a2 + hstepA, voffA);
            PG8_WAIT_V(8); PG8_WAIT_L(0); PG8_BAR; PG8_MMA(0, 0, At, B0); PG8_MMA(0, 1, At, B1); PG8_BAR; PG8_SCHED;
            PG8_LDA(At, 1, 1); PG8_STAGE(PG8_SB(1, 0), b3, voffB); PG8_STAGE(PG8_SB(1, 1), b3 + hstepB, voffB); PG8_STAGE(PG8_SA(1, 0), a3, voffA);
            PG8_WAIT_V(8); PG8_WAIT_L(0); PG8_BAR; PG8_MMA(1, 0, At, B0); PG8_MMA(1, 1, At, B1); PG8_BAR; PG8_SCHED;
            } else {
            PG8_LDB(B0, 0, 0); PG8_SCHED; PG8_LDA(At, 0, 0); PG8_STAGE(PG8_SA(1, 1), a1 + hstepA, voffA);
            PG8_WAIT_L(8); PG8_BAR; PG8_WAIT_L(0); PG8_MMA(0, 0, At, B0); PG8_BAR; PG8_SCHED;
            PG8_LDB(B1, 0, 1); PG8_STAGE(PG8_SB(0, 0), b2, voffB);
            PG8_BAR; PG8_WAIT_L(0); PG8_MMA(0, 1, At, B1); PG8_BAR;
            PG8_LDA(At, 0, 1); PG8_STAGE(PG8_SA(0, 0), a2, voffA);
            PG8_BAR; PG8_WAIT_L(0); PG8_MMA(1, 0, At, B0); PG8_BAR; PG8_SCHED;
            PG8_STAGE(PG8_SB(0, 1), b2 + hstepB, voffB);
            PG8_WAIT_V(6); PG8_BAR; PG8_MMA(1, 1, At, B1); PG8_BAR;
            PG8_LDB(B0, 1, 0); PG8_SCHED; PG8_LDA(At, 1, 0); PG8_STAGE(PG8_SA(0, 1), a2 + hstepA, voffA);
            PG8_WAIT_L(8); PG8_BAR; PG8_WAIT_L(0); PG8_MMA(0, 0, At, B0); PG8_BAR; PG8_SCHED;
            PG8_LDB(B1, 1, 1); PG8_STAGE(PG8_SB(1, 0), b3, voffB);
            PG8_BAR; PG8_WAIT_L(0); PG8_MMA(0, 1, At, B1); PG8_BAR;
            PG8_LDA(At, 1, 1); PG8_STAGE(PG8_SA(1, 0), a3, voffA);
            PG8_BAR; PG8_WAIT_L(0); PG8_MMA(1, 0, At, B0); PG8_BAR; PG8_SCHED;
            PG8_STAGE(PG8_SB(1, 1), b3 + hstepB, voffB);
            PG8_WAIT_V(6); PG8_BAR; PG8_MMA(1, 1, At, B1); PG8_BAR;
            }
        }
        if constexpr (ALIGN_EPI) { if (wr == 0) PG8_BAR; }
        if constexpr (!Epi::AFTER_DRAIN) { E(acc, cur, wr, wc, fr, fq); S.done(cur); }
        if (!has_next) break;
#pragma unroll
        for (int a = 0; a < 2; ++a)
#pragma unroll
            for (int b = 0; b < 2; ++b)
#pragma unroll
                for (int m = 0; m < 4; ++m)
#pragma unroll
                    for (int n = 0; n < 2; ++n) acc[a][b][m][n] = (f32x4){0.f, 0.f, 0.f, 0.f};
        cur = nxt; cA = nA; cB = nB; ++ui;
        if constexpr (ALIGN_EPI) { if (wr == 1) PG8_BAR; }
    }
    PG8_WAIT_V(0);
    if constexpr (!ALIGN_EPI) { if (wr == 0) PG8_BAR; }
    PG8_BAR;
    if constexpr (Epi::AFTER_DRAIN) { E.fused(acc, cur, wr, wc, fr, fq, lds, wid, lane); S.done(cur); }
#undef PG8_SA
#undef PG8_SB
#undef PG8_STAGE
#undef PG8_LDA
#undef PG8_LDB
#undef PG8_MMA
#undef PG8_WAIT_V
#undef PG8_WAIT_L
#undef PG8_BAR
#undef PG8_SCHED
}
}

namespace att {
constexpr int D = 128, NW = 8, QBLK = 32, KVBLK = 64, LDP = EVEN_IN;
constexpr float SCALE = 0.088388347648318440f, THR = 8.f;
constexpr size_t SHM_V = KVBLK * D * 2, SHM_K = KVBLK * D * 2, SHM_ATTN = 2 * SHM_V + 2 * SHM_K + NW * 64 * 4;
#define KSWZ(row, colB) ((row) * 256 + ((colB) ^ (((row) & 7) << 4)))
#define SBAR() __builtin_amdgcn_sched_barrier(0)
__device__ __forceinline__ int crow(int r, int hi) { return (r & 3) + 8 * (r >> 2) + 4 * hi; }

__device__ __forceinline__ void partialSM(f32x16& p0, f32x16& p1, float& m_reg, float& mn, float& alpha, bool nomax) {
  constexpr float C = SCALE * 1.4426950408889634f;
  if (nomax) { alpha = 1.f; mn = 0.f;
#pragma unroll
    for (int r = 0; r < 16; ++r) p0[r] = __builtin_amdgcn_exp2f(p0[r]);
    return; }
  float pmax = p0[0];
#pragma unroll
  for (int r = 1; r < 16; ++r) pmax = fmaxf(pmax, p0[r]);
#pragma unroll
  for (int r = 0; r < 16; ++r) pmax = fmaxf(pmax, p1[r]);
  { auto rr = __builtin_amdgcn_permlane32_swap(__float_as_uint(pmax), __float_as_uint(pmax), false, false);
    pmax = fmaxf(__uint_as_float(rr[0]), __uint_as_float(rr[1])); }
  if (__builtin_expect(__all(pmax - m_reg <= THR / SCALE), 1)) { mn = m_reg; alpha = 1.f; }
  else { mn = fmaxf(m_reg, pmax); alpha = __builtin_amdgcn_exp2f((m_reg - mn) * C); m_reg = mn; }
  float mnC = -mn * C;
#pragma unroll
  for (int r = 0; r < 16; ++r) p0[r] = fmaf(p0[r], C, mnC);
#pragma unroll
  for (int r = 0; r < 16; ++r) p1[r] = fmaf(p1[r], C, mnC);
#pragma unroll
  for (int r = 0; r < 16; ++r) p0[r] = __builtin_amdgcn_exp2f(p0[r]);
}
__device__ __forceinline__ void finishSM(f32x16& p0, f32x16& p1, float alpha, float& l_reg, bf16x8& pa0, bf16x8& pa1, bf16x8& pa2, bf16x8& pa3) {
#pragma unroll
  for (int r = 0; r < 16; ++r) p1[r] = __builtin_amdgcn_exp2f(p1[r]);
  float ps = 0;
#pragma unroll
  for (int r = 0; r < 16; ++r) ps += p0[r];
#pragma unroll
  for (int r = 0; r < 16; ++r) ps += p1[r];
  { auto rr = __builtin_amdgcn_permlane32_swap(__float_as_uint(ps), __float_as_uint(ps), false, false);
    ps = __uint_as_float(rr[0]) + __uint_as_float(rr[1]); }
  l_reg = l_reg * alpha + ps;
#define PK4(P, BASE, OUT) do { unsigned a0 = cvt_pk_bf16(P[BASE + 0], P[BASE + 1]), a1 = cvt_pk_bf16(P[BASE + 2], P[BASE + 3]);   \
    unsigned b0 = cvt_pk_bf16(P[BASE + 4], P[BASE + 5]), b1 = cvt_pk_bf16(P[BASE + 6], P[BASE + 7]);                              \
    auto r0 = __builtin_amdgcn_permlane32_swap(a0, b0, false, false); auto r1 = __builtin_amdgcn_permlane32_swap(a1, b1, false, false); \
    u32x4 w = {r0[0], r1[0], r0[1], r1[1]}; OUT = *reinterpret_cast<bf16x8*>(&w); } while (0)
  PK4(p0, 0, pa0); PK4(p0, 8, pa1); PK4(p1, 0, pa2); PK4(p1, 8, pa3);
#undef PK4
}
__device__ __forceinline__ void qkt(f32x16& p0, f32x16& p1, const bf16_t* Ks, const bf16x8* qr, int r32, int hi) {
  p0 = f32x16{}; p1 = f32x16{};
#pragma unroll
  for (int d0 = 0; d0 < 8; ++d0) { int cb = (d0 * 16 + hi * 8) * 2;
    bf16x8 b0 = *reinterpret_cast<const bf16x8*>((const char*)Ks + KSWZ(r32, cb));
    bf16x8 b1 = *reinterpret_cast<const bf16x8*>((const char*)Ks + KSWZ(32 + r32, cb));
    p0 = __builtin_amdgcn_mfma_f32_32x32x16_bf16(b0, qr[d0], p0, 0, 0, 0);
    p1 = __builtin_amdgcn_mfma_f32_32x32x16_bf16(b1, qr[d0], p1, 0, 0, 0); }
}
__device__ __forceinline__ int v_st(int k, int c) { const int kk = (k & ~0xC) | ((k & 4) << 1) | ((k & 8) >> 1); return ((kk >> 3) * 4 + (c >> 5)) * 512 + ((kk & 7) * 32 + (c & 31)) * 2; }
__device__ __forceinline__ int v_rd_base(int lane) { return ((lane & 3) << 3) | (((lane >> 2) & 3) << 6) | (((lane >> 4) & 1) << 5) | (((lane >> 5) & 1) << 8); }
constexpr int v_rd_off(int d0, int ks, int half) { return d0 * 512 + ks * 4096 + half * 2048; }
template <int OFF> __device__ __forceinline__ s16x4 tr_read(int vb) {
  s16x4 r; asm volatile("ds_read_b64_tr_b16 %0, %1 offset:%2" : "=&v"(r) : "v"(vb), "i"(OFF) : "memory"); return r;
}
template <int D0> __device__ __forceinline__ void pv_one(f32x16& od, int vb, bf16x8 pa0, bf16x8 pa1, bf16x8 pa2, bf16x8 pa3) {
  const s16x4 l0 = tr_read<v_rd_off(D0, 0, 0)>(vb), h0 = tr_read<v_rd_off(D0, 0, 1)>(vb), l1 = tr_read<v_rd_off(D0, 1, 0)>(vb), h1 = tr_read<v_rd_off(D0, 1, 1)>(vb);
  const s16x4 l2 = tr_read<v_rd_off(D0, 2, 0)>(vb), h2 = tr_read<v_rd_off(D0, 2, 1)>(vb), l3 = tr_read<v_rd_off(D0, 3, 0)>(vb), h3 = tr_read<v_rd_off(D0, 3, 1)>(vb);
  asm volatile("s_waitcnt lgkmcnt(0)" ::: "memory"); SBAR();
#define PK(L, H) (bf16x8){L[0], L[1], L[2], L[3], H[0], H[1], H[2], H[3]}
  od = __builtin_amdgcn_mfma_f32_32x32x16_bf16(pa0, PK(l0, h0), od, 0, 0, 0);
  od = __builtin_amdgcn_mfma_f32_32x32x16_bf16(pa1, PK(l1, h1), od, 0, 0, 0);
  od = __builtin_amdgcn_mfma_f32_32x32x16_bf16(pa2, PK(l2, h2), od, 0, 0, 0);
  od = __builtin_amdgcn_mfma_f32_32x32x16_bf16(pa3, PK(l3, h3), od, 0, 0, 0);
#undef PK
}
__device__ __forceinline__ void pv_d0(f32x16* o, int vb, bf16x8 pa0, bf16x8 pa1, bf16x8 pa2, bf16x8 pa3) {
  pv_one<0>(o[0], vb, pa0, pa1, pa2, pa3); pv_one<1>(o[1], vb, pa0, pa1, pa2, pa3); pv_one<2>(o[2], vb, pa0, pa1, pa2, pa3); pv_one<3>(o[3], vb, pa0, pa1, pa2, pa3);
}

template <bool WIN>
__device__ __forceinline__ void attn_unit(const bf16_t* __restrict__ Qb, const bf16_t* __restrict__ Kc, const bf16_t* __restrict__ Vc, const bf16_t* __restrict__ Zb,
                                          bf16_t* __restrict__ Yb, long lat0, long ctx0, int q0, float sinkv, bool nomax, char* lds) {
  const int tid = threadIdx.x, wid = tid >> 6, lane = tid & 63, r32 = lane & 31, hi = lane >> 5;
  bf16_t* V_lds = (bf16_t*)lds; bf16_t* K_lds = (bf16_t*)(lds + 2 * SHM_V);
  float* ws = (float*)(lds + 2 * SHM_V + 2 * SHM_K) + wid * 64; float* li_l = ws; float* al_l = ws + 32;
  float m_reg = -1e30f, l_reg = 0; f32x16 o[4] = {}; bf16x8 qr[8];
  const int qoff = (wid * QBLK + r32) * LDP + hi * 8;
#pragma unroll
  for (int d0 = 0; d0 < 8; ++d0) qr[d0] = *reinterpret_cast<const bf16x8*>(Qb + qoff + d0 * 16);
  const int sr = tid >> 4, sc = (tid & 15) * 8, vst0 = v_st(sr, sc), vst1 = v_st(32 + sr, sc);
  const int vb0 = (int)(uintptr_t)V_lds + v_rd_base(lane);
  const int tb0 = WIN ? ((q0 / 64 - 2) > 0 ? (q0 / 64 - 2) : 0) : 0;
  const int tb1 = WIN ? ((q0 / 64 + 5) < 255 ? (q0 / 64 + 5) : 255) : 0;
  const int NT = WIN ? (4 + tb1 - tb0 + 1) : (SEQ / KVBLK + CTX / KVBLK);
#define TROW(t) (WIN ? ((t) < 4 ? ctx0 + 64 * (t) : lat0 + 64 * (long)(tb0 + (t) - 4)) : ((t) < SEQ / KVBLK ? lat0 + 64 * (long)(t) : ctx0 + 64 * (long)((t) - SEQ / KVBLK)))
  struct { bf16x8 vs0, vs1, ks0, ks1; } sr_[2];
  const int ldo0 = sr * LDP + sc, ldo1 = (32 + sr) * LDP + sc;
#define SLOAD(i, t) do { const long R_ = TROW(t); const bf16_t* vt_ = Vc + R_ * LDP; const bf16_t* kt_ = Kc + R_ * LDP; \
    sr_[i].vs0 = *reinterpret_cast<const bf16x8*>(vt_ + ldo0); sr_[i].vs1 = *reinterpret_cast<const bf16x8*>(vt_ + ldo1); \
    sr_[i].ks0 = *reinterpret_cast<const bf16x8*>(kt_ + ldo0); sr_[i].ks1 = *reinterpret_cast<const bf16x8*>(kt_ + ldo1); } while (0)
#define SWRITE(b, i) do { *(bf16x8*)((char*)V_lds + (b) * SHM_V + vst0) = sr_[i].vs0;          \
    *(bf16x8*)((char*)V_lds + (b) * SHM_V + vst1) = sr_[i].vs1; int kc = sc * 2;               \
    *(bf16x8*)((char*)K_lds + (b) * SHM_K + KSWZ(sr, kc)) = sr_[i].ks0;                       \
    *(bf16x8*)((char*)K_lds + (b) * SHM_K + KSWZ(32 + sr, kc)) = sr_[i].ks1; } while (0)
#define SWAIT() asm volatile("s_waitcnt vmcnt(4)" ::: "memory")
#define RESC(a) do { if (__any((a) < 1.f)) { if (hi == 0) al_l[r32] = (a); asm volatile("s_waitcnt lgkmcnt(0)" ::: "memory"); \
    _Pragma("unroll") for (int d = 0; d < 4; ++d) _Pragma("unroll") for (int r = 0; r < 16; ++r) o[d][r] *= al_l[crow(r, hi)]; } } while (0)
#define MASKT(P0, P1, t) do { if (WIN && (t) >= 4) { const int dk_ = 64 * (tb0 + (t) - 4) - (q0 + wid * QBLK + r32); \
    _Pragma("unroll") for (int r = 0; r < 16; ++r) { const int d_ = dk_ + crow(r, hi); \
      if (d_ > 128 || d_ < -128) P0[r] = -1e30f; if (d_ + 32 > 128 || d_ + 32 < -128) P1[r] = -1e30f; } } } while (0)
  f32x16 pA0, pA1, pB0, pB1; float mnA, mnB, alA, alB; bf16x8 pa0, pa1, pa2, pa3;
  constexpr int SE = 0, SO = 1;
  SLOAD(SE, 0); asm volatile("s_waitcnt vmcnt(0)" ::: "memory"); SWRITE(0, SE); __syncthreads();
  qkt(pA0, pA1, K_lds, qr, r32, hi); MASKT(pA0, pA1, 0); partialSM(pA0, pA1, m_reg, mnA, alA, nomax);
  SLOAD(SO, 1); if (2 < NT) SLOAD(SE, 2);
  SWAIT(); SWRITE(1, SO); __syncthreads();
  for (int j = 1; j + 1 < NT; j += 2) {
    SBAR(); qkt(pB0, pB1, (bf16_t*)((char*)K_lds + SHM_K), qr, r32, hi);
    finishSM(pA0, pA1, alA, l_reg, pa0, pa1, pa2, pa3); SBAR();
    SLOAD(SO, j + 2); SBAR();
    pv_d0(o, vb0, pa0, pa1, pa2, pa3); MASKT(pB0, pB1, j); partialSM(pB0, pB1, m_reg, mnB, alB, nomax);
    __syncthreads(); SWAIT(); SWRITE(0, SE);
    RESC(alB); __syncthreads();
    SBAR(); qkt(pA0, pA1, K_lds, qr, r32, hi);
    finishSM(pB0, pB1, alB, l_reg, pa0, pa1, pa2, pa3); SBAR();
    if (j + 3 < NT) SLOAD(SE, j + 3); SBAR();
    pv_d0(o, vb0 + (int)SHM_V, pa0, pa1, pa2, pa3); MASKT(pA0, pA1, j + 1); partialSM(pA0, pA1, m_reg, mnA, alA, nomax);
    __syncthreads(); SWAIT(); SWRITE(1, SO);
    RESC(alA); __syncthreads();
  }
  SBAR(); qkt(pB0, pB1, (bf16_t*)((char*)K_lds + SHM_K), qr, r32, hi);
  finishSM(pA0, pA1, alA, l_reg, pa0, pa1, pa2, pa3); SBAR();
  pv_d0(o, vb0, pa0, pa1, pa2, pa3); MASKT(pB0, pB1, NT - 1); partialSM(pB0, pB1, m_reg, mnB, alB, nomax);
  __syncthreads(); RESC(alB);
  finishSM(pB0, pB1, alB, l_reg, pa0, pa1, pa2, pa3); SBAR();
  pv_d0(o, vb0 + (int)SHM_V, pa0, pa1, pa2, pa3);
  if (WIN) l_reg += __builtin_amdgcn_exp2f(sinkv * 1.4426950408889634f - m_reg * (SCALE * 1.4426950408889634f));
  if (hi == 0) li_l[r32] = l_reg; asm volatile("s_waitcnt lgkmcnt(0)" ::: "memory");
  float rli[16];
#pragma unroll
  for (int r = 0; r < 16; ++r) rli[r] = __builtin_amdgcn_rcpf(li_l[4 * hi + (r & 3) + 8 * (r >> 2)]);
  __syncthreads();
  { bf16_t* stg = (bf16_t*)lds + wid * (QBLK * D); bf16_t* sp = stg + (4 * hi) * D + r32;
#pragma unroll
    for (int r = 0; r < 16; ++r) {
#pragma unroll
      for (int d0 = 0; d0 < 4; ++d0) { const float y = o[d0][r] * rli[r]; sp[((r & 3) + 8 * (r >> 2)) * D + d0 * 32] = (bf16_t)(cvt_pk_bf16(y, y) & 0xffffu); } }
    asm volatile("s_waitcnt lgkmcnt(0)" ::: "memory");
    const int row0 = lane >> 4, ch = (lane & 15) * 8;
    const int zoff = (wid * QBLK + row0) * LDP + ch, yoff = (wid * QBLK + row0) * DM + ch; const bf16_t* sq = stg + row0 * D + ch;
#pragma unroll
    for (int i = 0; i < 8; ++i) {
      const u32x4 v = *(const u32x4*)(sq + i * 4 * D); const u32x4 z = *(const u32x4*)(Zb + zoff + i * 4 * LDP);
      u32x4 w; w.x = cvt_pk_bf16(bf_lo(v.x) * bf_lo(z.x), bf_hi(v.x) * bf_hi(z.x)); w.y = cvt_pk_bf16(bf_lo(v.y) * bf_lo(z.y), bf_hi(v.y) * bf_hi(z.y));
      w.z = cvt_pk_bf16(bf_lo(v.z) * bf_lo(z.z), bf_hi(v.z) * bf_hi(z.z)); w.w = cvt_pk_bf16(bf_lo(v.w) * bf_lo(z.w), bf_hi(v.w) * bf_hi(z.w));
      *(u32x4*)(Yb + yoff + i * 4 * DM) = w; } }
  __syncthreads();
#undef TROW
#undef SLOAD
#undef SWRITE
#undef SWAIT
#undef RESC
#undef MASKT
}
}

constexpr size_t MiB = 1u << 20;
constexpr size_t WS_MODP = 0;
constexpr size_t WS_MOD = 8 * MiB;
constexpr size_t WS_ROPE = 9 * MiB;
constexpr size_t WS_BAR = 9 * MiB + 512 * 1024;
constexpr size_t WS_W0IN = 10 * MiB;
constexpr size_t WS_W0OUT = 30 * MiB;
constexpr size_t WS_W1IN = 38 * MiB;
constexpr size_t WS_WPOOL = 54 * MiB;
constexpr size_t WS_W1OUT = 56 * MiB;
constexpr size_t WS_H = 64 * MiB;
constexpr size_t WS_P = 196 * MiB;
constexpr size_t WS_Y = 524 * MiB;
constexpr size_t WS_T = 652 * MiB;
constexpr size_t WS_END = 780 * MiB;
constexpr int LDS_BYTES = 147456, MISC_OFF = 131072 + 320;
#ifndef ATT_SEL
#define ATT_SEL 3
#endif

#define XB_TMO      128
#define XB_XCNT(j)  (256  + 64 * (j))
#define XB_XSUB(j)  (1280 + 64 * (j))
#define XB_XGEN(j)  (2304 + 64 * (j))
#define XB_TOP      3328
#define XB_TOPGEN   3392
#define XCD_BAR_WORDS 3456
#define XB_SPIN_CAP (1u << 18)

__device__ __forceinline__ unsigned xb_ld(unsigned* p)              { return __hip_atomic_load(p, __ATOMIC_RELAXED, __HIP_MEMORY_SCOPE_AGENT); }
__device__ __forceinline__ unsigned xb_add(unsigned* p, unsigned v) { return __hip_atomic_fetch_add(p, v, __ATOMIC_RELAXED, __HIP_MEMORY_SCOPE_AGENT); }
__device__ __forceinline__ unsigned xb_xcc_id() { return (unsigned)__builtin_amdgcn_s_getreg((3 << 11) | 20) & 0xFu; }
#define XB_SPIN(cond, bar) do { unsigned _sp = 0; while (cond) { __builtin_amdgcn_s_sleep(1); \
    if ((++_sp & 255u) == 0u) { if (xb_ld(&(bar)[XB_TMO])) break; if (_sp > XB_SPIN_CAP) { atomicAdd(&(bar)[XB_TMO], 1u); break; } } } } while (0)

struct XcdBarrier {
    unsigned* bar; unsigned x;
    volatile LAS unsigned* st;
};

__device__ __forceinline__ XcdBarrier xcd_barrier_post(unsigned* bar, volatile LAS unsigned* st) {
    XcdBarrier b; b.bar = bar; b.x = xb_xcc_id(); b.st = st;
    if (threadIdx.x == 0) (void)xb_add(&bar[XB_XCNT(b.x)], 1u);
    return b;
}
__device__ __forceinline__ void xcd_barrier_complete(unsigned* bar, unsigned x, unsigned& nloc, unsigned& nx) {
    const unsigned G = gridDim.x * gridDim.y * gridDim.z;
    unsigned sum, cnt, mine, sp = 0u;
    for (;;) {
        sum = 0u; cnt = 0u; mine = 0u;
#pragma unroll
        for (unsigned j = 0; j < 16; ++j) { const unsigned c = xb_ld(&bar[XB_XCNT(j)]); sum += c; cnt += (c > 0u) ? 1u : 0u; mine = (j == x) ? c : mine; }
        if (sum == G) break;
        __builtin_amdgcn_s_sleep(1);
        if ((++sp & 255u) == 0u) { if (xb_ld(&bar[XB_TMO])) break; if (sp > XB_SPIN_CAP) { atomicAdd(&bar[XB_TMO], 1u); break; } }
    }
    nloc = mine > 0u ? mine : 1u; nx = cnt > 0u ? cnt : 1u;
}

__device__ __forceinline__ void xcd_barrier(const XcdBarrier& b) {
    asm volatile("s_waitcnt vmcnt(0)" ::: "memory");
    __syncthreads();
    if (threadIdx.x == 0) {
        unsigned* bar = b.bar;
        __builtin_amdgcn_s_waitcnt(0);
        unsigned nloc = b.st[0], nx = b.st[1];
        if (nloc == 0u) { xcd_barrier_complete(bar, b.x, nloc, nx); b.st[0] = nloc; b.st[1] = nx; }
        const unsigned old = xb_add(&bar[XB_XSUB(b.x)], 1u);
        const unsigned gen = old / nloc;
        if (old + 1u == (gen + 1u) * nloc) {
            __builtin_amdgcn_fence(__ATOMIC_RELEASE, "agent");
            asm volatile("s_waitcnt vmcnt(0)" ::: "memory");
            const unsigned og = xb_add(&bar[XB_TOP], 1u);
            const unsigned tg = og / nx;
            if (og + 1u == (tg + 1u) * nx) xb_add(&bar[XB_TOPGEN], 1u);
            else XB_SPIN(xb_ld(&bar[XB_TOPGEN]) == tg, bar);
            __builtin_amdgcn_fence(__ATOMIC_ACQUIRE, "agent");
            xb_add(&bar[XB_XGEN(b.x)], 1u);
            asm volatile("s_waitcnt vmcnt(0)" ::: "memory");
        } else {
            XB_SPIN(xb_ld(&bar[XB_XGEN(b.x)]) == gen, bar);
            __builtin_amdgcn_fence(__ATOMIC_ACQUIRE, "agent");
            asm volatile("s_waitcnt vmcnt(0)" ::: "memory");
        }
    }
    __syncthreads();
}

struct Args { const float* in[21]; float* out; unsigned char* ws; double cs1[32], sn1[32]; int ph_lo, ph_hi; };

__device__ __forceinline__ float wave_sum(float v) {
#pragma unroll
    for (int o = 1; o < 64; o <<= 1) v += __shfl_xor(v, o);
    return v;
}
__device__ __forceinline__ unsigned f2bf(float f) { unsigned u = __builtin_bit_cast(unsigned, f); return (u + 0x7fffu + ((u >> 16) & 1u)) >> 16; }
__device__ __forceinline__ unsigned pk2(float lo, float hi) { return f2bf(lo) | (f2bf(hi) << 16); }

__device__ __forceinline__ void transpose_item(const float* W, int K, int N, bf16_t* WT, int row_off, LAS float* scr, int item, int lane) {
    const int nblk = N / 32, kb = item / nblk, nb = item % nblk, k0 = 64 * kb, n0 = 32 * nb;
#pragma unroll 8
    for (int i = 0; i < 32; ++i) { const int kk = 2 * i + (lane >> 5); scr[kk * 33 + (lane & 31)] = W[(size_t)(k0 + kk) * N + n0 + (lane & 31)]; }
    asm volatile("s_waitcnt lgkmcnt(0)" ::: "memory");
    const int c = lane & 7;
#pragma unroll
    for (int j = 0; j < 4; ++j) { const int n = (lane >> 3) + 8 * j; const LAS float* s = scr + (8 * c) * 33 + n;
        u32x4 o; o.x = pk2(s[0 * 33], s[1 * 33]); o.y = pk2(s[2 * 33], s[3 * 33]); o.z = pk2(s[4 * 33], s[5 * 33]); o.w = pk2(s[6 * 33], s[7 * 33]);
        *(u32x4*)(WT + (size_t)(row_off + n0 + n) * K + k0 + 8 * c) = o; }
    asm volatile("s_waitcnt lgkmcnt(0)" ::: "memory");
}

__device__ __forceinline__ void prenorm_row(const float* xrow, const float* g, const float* shift, const float* scale, bf16_t* orow, int lane) {
    f32x4 v[8]; float s = 0.f;
#pragma unroll
    for (int j = 0; j < 8; ++j) { v[j] = *(const f32x4*)(xrow + 4 * lane + 256 * j); s += (v[j].x * v[j].x + v[j].y * v[j].y) + (v[j].z * v[j].z + v[j].w * v[j].w); }
    const float rstd = 1.0f / sqrtf(wave_sum(s) * (1.f / DM) + EPS);
#pragma unroll
    for (int j = 0; j < 8; ++j) { const int c = 4 * lane + 256 * j; const f32x4 gg = *(const f32x4*)(g + c), sh = *(const f32x4*)(shift + c), sc = *(const f32x4*)(scale + c);
        const f32x4 y = v[j] * rstd * gg * (sc + 1.0f) + sh;
        u32x2 w; w.x = cvt_pk_bf16(y.x, y.y); w.y = cvt_pk_bf16(y.z, y.w); *(u32x2*)(orow + c) = w; }
}
template <bool NEXT>
__device__ __forceinline__ void postnorm_row(const bf16_t* trow, const float* xres, const float* post_g, const float* gate, float* xout,
                                             const float* g2, const float* shift2, const float* scale2, bf16_t* hrow, int lane) {
    f32x4 t[8]; float s = 0.f;
#pragma unroll
    for (int j = 0; j < 8; ++j) { const u32x2 w = *(const u32x2*)(trow + 4 * lane + 256 * j); t[j] = (f32x4){bf_lo(w.x), bf_hi(w.x), bf_lo(w.y), bf_hi(w.y)};
        s += (t[j].x * t[j].x + t[j].y * t[j].y) + (t[j].z * t[j].z + t[j].w * t[j].w); }
    const float rstd = 1.0f / sqrtf(wave_sum(s) * (1.f / DM) + EPS);
    float s2 = 0.f;
#pragma unroll
    for (int j = 0; j < 8; ++j) { const int c = 4 * lane + 256 * j; const f32x4 pg = *(const f32x4*)(post_g + c), ga = *(const f32x4*)(gate + c), xr = *(const f32x4*)(xres + c);
        t[j] = xr + ga * (t[j] * rstd * pg); *(f32x4*)(xout + c) = t[j];
        s2 += (t[j].x * t[j].x + t[j].y * t[j].y) + (t[j].z * t[j].z + t[j].w * t[j].w); }
    if (NEXT) {
        const float rstd2 = 1.0f / sqrtf(wave_sum(s2) * (1.f / DM) + EPS);
#pragma unroll
        for (int j = 0; j < 8; ++j) { const int c = 4 * lane + 256 * j; const f32x4 gg = *(const f32x4*)(g2 + c), sh = *(const f32x4*)(shift2 + c), sc = *(const f32x4*)(scale2 + c);
            const f32x4 y = t[j] * rstd2 * gg * (sc + 1.0f) + sh;
            u32x2 w; w.x = cvt_pk_bf16(y.x, y.y); w.y = cvt_pk_bf16(y.z, y.w); *(u32x2*)(hrow + c) = w; }
    }
}

template <int H>
__device__ __forceinline__ void pool_chunk(const bf16_t* __restrict__ Pp, bf16_t* __restrict__ Hp, size_t base, int t0, int cg8) {
    constexpr int NR = 8 + 2 * H - 1;
    u32x4 w[NR];
#pragma unroll
    for (int i = 0; i < NR; ++i) { const int t = t0 - H + i; w[i] = (u32x4){0u, 0u, 0u, 0u}; if (t >= 0 && t < SEQ) w[i] = *(const u32x4*)(Pp + (base + t) * ODD_IN + cg8); }
    float S[8] = {0.f, 0.f, 0.f, 0.f, 0.f, 0.f, 0.f, 0.f};
#pragma unroll
    for (int i = 0; i < 2 * H; ++i) { S[0] += bf_lo(w[i].x); S[1] += bf_hi(w[i].x); S[2] += bf_lo(w[i].y); S[3] += bf_hi(w[i].y); S[4] += bf_lo(w[i].z); S[5] += bf_hi(w[i].z); S[6] += bf_lo(w[i].w); S[7] += bf_hi(w[i].w); }
#pragma unroll
    for (int r = 0; r < 8; ++r) { const int t = t0 + r; const int tlo = (t - H) > 0 ? (t - H) : 0, thi = (t + H) < SEQ ? (t + H) : SEQ; const float inv = 1.0f / (float)(thi - tlo);
        const u32x4 ow = w[r + H];
        u32x4 o; o.x = cvt_pk_bf16(S[0] * inv - bf_lo(ow.x), S[1] * inv - bf_hi(ow.x)); o.y = cvt_pk_bf16(S[2] * inv - bf_lo(ow.y), S[3] * inv - bf_hi(ow.y));
        o.z = cvt_pk_bf16(S[4] * inv - bf_lo(ow.z), S[5] * inv - bf_hi(ow.z)); o.w = cvt_pk_bf16(S[6] * inv - bf_lo(ow.w), S[7] * inv - bf_hi(ow.w));
        *(u32x4*)(Hp + (base + t) * DM + cg8) = o;
        if (r < 7) { const u32x4 a = w[r + 2 * H], d = w[r];
            S[0] += bf_lo(a.x) - bf_lo(d.x); S[1] += bf_hi(a.x) - bf_hi(d.x); S[2] += bf_lo(a.y) - bf_lo(d.y); S[3] += bf_hi(a.y) - bf_hi(d.y);
            S[4] += bf_lo(a.z) - bf_lo(d.z); S[5] += bf_hi(a.z) - bf_hi(d.z); S[6] += bf_lo(a.w) - bf_lo(d.w); S[7] += bf_hi(a.w) - bf_hi(d.w); } }
}

__global__ void __launch_bounds__(512, 2) mk_fwd(Args args) {
    extern __shared__ __attribute__((aligned(16))) unsigned char lds[];
    cg::grid_group grid = cg::this_grid();
    const int tid = threadIdx.x, lane = tid & 63, wave = __builtin_amdgcn_readfirstlane(tid >> 6);
    const int G = gridDim.x, bx = blockIdx.x;
    const int vcu = (G % 8 == 0) ? (bx % 8) * (G / 8) + bx / 8 : bx;
    const int gw = vcu * 8 + wave, NGW = G * 8;
    unsigned char* ws = args.ws;
    const float* x = args.in[0]; const float* cvec = args.in[1]; const float* ctx = args.in[2]; const float* c_ctx = args.in[3];
    float* modp = (float*)(ws + WS_MODP); float* mod = (float*)(ws + WS_MOD);
    float* rowtab = (float*)(ws + WS_ROPE); float* coltab = rowtab + 256 * 32 * 2;
    bf16_t* W0in = (bf16_t*)(ws + WS_W0IN); bf16_t* W0out = (bf16_t*)(ws + WS_W0OUT); bf16_t* W1in = (bf16_t*)(ws + WS_W1IN);
    bf16_t* Wpool = (bf16_t*)(ws + WS_WPOOL); bf16_t* W1out = (bf16_t*)(ws + WS_W1OUT);
    bf16_t* Hb = (bf16_t*)(ws + WS_H); bf16_t* Pb = (bf16_t*)(ws + WS_P); bf16_t* Yb = (bf16_t*)(ws + WS_Y); bf16_t* Tb = (bf16_t*)(ws + WS_T);
    float* out = args.out;
    const int lo = args.ph_lo, hi = args.ph_hi;
    volatile LAS unsigned* MISC = (volatile LAS unsigned*)((LAS unsigned char*)lds + MISC_OFF);
    if (tid < 32) MISC[tid] = 0u;
    __syncthreads();
    if (lo < 0) { __threadfence(); grid.sync(); __threadfence(); }
    XcdBarrier bar = xcd_barrier_post((unsigned*)(ws + WS_BAR), MISC + 8);
#ifndef MK_MASK
#define MK_MASK 0x1fff
#endif
#define IN(k) (((MK_MASK >> (k)) & 1) && lo <= (k) && (k) < hi)
#ifndef MK_DUP
#define MK_DUP 0
#endif
#define REP(k) for (int rep_ = 0; rep_ < (((MK_DUP >> (k)) & 1) ? 2 : 1); ++rep_)
#define SEAM(k) do { if (IN(k) && IN((k) + 1)) xcd_barrier(bar); } while (0)

    if (IN(0)) REP(0) {
        {
            LAS float* sl = (LAS float*)lds;
            for (int i = tid; i < 3 * DM; i += 512) { const float v = i < 2 * DM ? cvec[i] : c_ctx[i - 2 * DM]; sl[i] = silu_f(v); }
            __syncthreads();
            for (int it = bx; it < 2 * 12 * 32; it += G) {
                const int l = it / 384, cb = (it % 384) / 32, kc = it % 32; const float* W = args.in[l ? 13 : 4]; const int j = cb * 512 + tid;
                float s0 = 0.f, s1 = 0.f, s2 = 0.f;
#pragma unroll 8
                for (int k = kc * 64; k < kc * 64 + 64; ++k) { const float w = W[(size_t)k * (3 * DM) + j]; s0 += sl[k] * w; s1 += sl[DM + k] * w; s2 += sl[2 * DM + k] * w; }
                float* pp = modp + ((size_t)(l * 32 + kc) * 3) * (3 * DM) + j; pp[0] = s0; pp[3 * DM] = s1; pp[2 * 3 * DM] = s2;
            }
            __syncthreads();
        }
        {
            LAS float* scr = (LAS float*)(lds + wave * 16384);
            constexpr int I0 = (DM / 64) * (EVEN_IN / 32), I1 = (DM / 64) * (DM / 32), I2 = (DM / 64) * (ODD_IN / 32), I3 = 4 * (512 / 64) * (512 / 32), I4 = I1;
            for (int it = gw; it < I0 + I1 + I2 + I3 + I4; it += NGW) {
                int r = it;
                if (r < I0) { transpose_item(args.in[8], DM, EVEN_IN, W0in, 0, scr, r, lane); continue; } r -= I0;
                if (r < I1) { transpose_item(args.in[12], DM, DM, W0out, 0, scr, r, lane); continue; } r -= I1;
                if (r < I2) { transpose_item(args.in[17], DM, ODD_IN, W1in, 0, scr, r, lane); continue; } r -= I2;
                if (r < I3) { const int g = r / 128; transpose_item(args.in[18] + (size_t)g * 512 * 512, 512, 512, Wpool, g * 512, scr, r % 128, lane); continue; } r -= I3;
                transpose_item(args.in[20], DM, DM, W1out, 0, scr, r, lane);
            }
        }
        if (bx == 0 && tid < 32) {
            const double c1 = args.cs1[tid], s1 = args.sn1[tid]; double c = 1.0, s = 0.0;
            for (int n = 0; n < 256; ++n) { rowtab[(n * 32 + tid) * 2] = (float)c; rowtab[(n * 32 + tid) * 2 + 1] = (float)s;
                if (n < 64) { coltab[(n * 32 + tid) * 2] = (float)c; coltab[(n * 32 + tid) * 2 + 1] = (float)s; }
                const double cn = c * c1 - s * s1, sn = s * c1 + c * s1; c = cn; s = sn; }
        }
    }
    SEAM(0);
    if (IN(1)) {
        for (int i = bx * 512 + tid; i < 2 * 3 * 3 * DM; i += G * 512) {
            const int l = i / (9 * DM), v = (i / (3 * DM)) % 3, j = i % (3 * DM); float s = args.in[l ? 14 : 5][j];
            for (int kc = 0; kc < 32; ++kc) s += modp[((size_t)(l * 32 + kc) * 3 + v) * (3 * DM) + j];
            mod[i] = s;
        }
        if (bx == 0 && tid < 64) {
            float gq = fmaxf(fabsf(args.in[9][tid]), fabsf(args.in[9][tid + 64])), gk = fmaxf(fabsf(args.in[10][tid]), fabsf(args.in[10][tid + 64]));
#pragma unroll
            for (int o_ = 1; o_ < 64; o_ <<= 1) { gq = fmaxf(gq, __shfl_xor(gq, o_)); gk = fmaxf(gk, __shfl_xor(gk, o_)); }
            const float bound_log2 = 11.3137085f * 1.4426950408889634f * 1.02f * gq * gk;
            if (tid == 0) mod[2 * 3 * 3 * DM] = (bound_log2 <= 60.f) ? 1.f : 0.f;
        }
    }
    SEAM(1);
    if (IN(2)) REP(2) {
        for (int m = gw; m < MALL; m += NGW) {
            const float* xr; int v;
            if (m < MLAT) { xr = x + (size_t)m * DM; v = m / SEQ; } else { xr = ctx + (size_t)(m - MLAT) * DM; v = 2; }
            const float* mv = mod + (size_t)v * 3 * DM;
            prenorm_row(xr, args.in[6], mv, mv + DM, Hb + (size_t)m * DM, lane);
        }
    }
    SEAM(2);
    if (IN(3)) REP(3) {
        pg8::Gemm g{Hb, W0in, MALL, EVEN_IN, DM, DM, DM, 1 << 20}; pg8::StaticOrder S; S.init(MALL, EVEN_IN, G, bx);
        pg8::EpiMk E{Pb, EVEN_IN, COL_Z, nullptr, nullptr, 0};
        pg8::gemm_phase<pg8::EpiMk, pg8::StaticOrder, true, true>((LAS unsigned char*)lds, g, S, E);
    }
    SEAM(3);
    if (IN(4)) {
        const float* qn = args.in[9]; const float* kn = args.in[10];
        const int sub = lane & 15, e0 = sub * 8, i0 = (sub & 7) * 8, hq = lane >> 4; const bool upper = sub >= 8;
        const float qsc = (mod[2 * 3 * 3 * DM] != 0.f) ? (0.088388347648318440f * 1.4426950408889634f) : 1.f;
        float gq[8], gk[8];
#pragma unroll
        for (int e = 0; e < 8; ++e) { gq[e] = qn[e0 + e] * qsc; gk[e] = kn[e0 + e]; }
        for (int m = gw; m < MALL; m += NGW) {
            const bool isctx = m >= MLAT;
            bf16_t* prow_ = Pb + (size_t)m * EVEN_IN + hq * HD + e0;
            u32x4 w[6];
#pragma unroll
            for (int hg = 0; hg < 6; ++hg) w[hg] = *(const u32x4*)(prow_ + hg * 4 * HD);
            const int t = m & (SEQ - 1); const int prow = t >> 6, pcol = t & 63;
            const float* tab = (i0 < 32) ? (rowtab + (prow * 32 + i0) * 2) : (coltab + (pcol * 32 + (i0 - 32)) * 2);
            f32x4 tb[4];
#pragma unroll
            for (int q = 0; q < 4; ++q) tb[q] = *(const f32x4*)(tab + 4 * q);
#pragma unroll
            for (int hg = 0; hg < 6; ++hg) {
                const int hd = hg * 4 + hq;
                const bool is_qa = hg < 2, is_ka = (hg == 4 && hq < 2), is_v = (hg >= 4 && hq >= 2);
                const bool do_norm = is_qa || is_ka, do_rope = !is_v && !isctx;
                float v[8] = {bf_lo(w[hg].x), bf_hi(w[hg].x), bf_lo(w[hg].y), bf_hi(w[hg].y), bf_lo(w[hg].z), bf_hi(w[hg].z), bf_lo(w[hg].w), bf_hi(w[hg].w)};
                if (hg < 2 || hg == 4) {
                    float ss = 0.f;
#pragma unroll
                    for (int e = 0; e < 8; ++e) ss += v[e] * v[e];
                    ss += __shfl_xor(ss, 1); ss += __shfl_xor(ss, 2); ss += __shfl_xor(ss, 4); ss += __shfl_xor(ss, 8);
                    if (do_norm) { const float rstd = 1.0f / sqrtf(ss * (1.f / HD) + EPS);
#pragma unroll
                        for (int e = 0; e < 8; ++e) v[e] = v[e] * rstd * (is_qa ? gq[e] : gk[e]); }
                }
                float r[8];
#pragma unroll
                for (int e = 0; e < 8; ++e) { const float oth = __shfl_xor(v[e], 8); float cs = 1.f, sn = 0.f; if (do_rope) { cs = tb[e >> 1][(e & 1) * 2]; sn = tb[e >> 1][(e & 1) * 2 + 1]; }
                    r[e] = upper ? (v[e] * cs + oth * sn) : (v[e] * cs - oth * sn); }
                (void)hd;
                if (!is_v && (!isctx || is_ka)) { u32x4 o; o.x = cvt_pk_bf16(r[0], r[1]); o.y = cvt_pk_bf16(r[2], r[3]); o.z = cvt_pk_bf16(r[4], r[5]); o.w = cvt_pk_bf16(r[6], r[7]); *(u32x4*)(prow_ + hg * 4 * HD) = o; }
            }
        }
    }
    SEAM(4);
    if (IN(5)) REP(5) {
        const float* sink = args.in[11]; const bool fastA = __builtin_amdgcn_readfirstlane(mod[2 * 3 * 3 * DM] != 0.f ? 1 : 0) != 0;
#define ATT_UNIT_SETUP const int uu = u & 1023; const int combo = (uu & 255) >> 6, qb = uu & 63, gq = uu >> 8;   \
            const int b = combo >> 1, kv = combo & 1; const long lat0 = (long)b * SEQ, ctx0 = (long)MLAT + (long)b * CTX; const int q0 = qb * 256; \
            const bf16_t* Qp = Pb + (size_t)(lat0 + q0) * EVEN_IN + COL_Q + head * HD; const bf16_t* Zp = Pb + (size_t)(lat0 + q0) * EVEN_IN + COL_Z + head * HD; \
            bf16_t* Yp = Yb + (size_t)(lat0 + q0) * DM + head * HD;
        if (ATT_SEL & 1) for (int u = vcu; u < 1024; u += G) {
            const int head = (((u & 255) >> 6) & 1) * 4 + (u >> 8);
            ATT_UNIT_SETUP
            att::attn_unit<false>(Qp, Pb + COL_KA + kv * HD, Pb + COL_VA + kv * HD, Zp, Yp, lat0, ctx0, q0, 0.f, fastA, (char*)lds);
        }
        if (ATT_SEL & 2) {
            unsigned* ctr = (unsigned*)(args.ws + WS_BAR) + 3584;
            for (;;) {
                __syncthreads();
                if (tid == 0) MISC[16] = __hip_atomic_fetch_add(ctr, 1u, __ATOMIC_RELAXED, __HIP_MEMORY_SCOPE_AGENT);
                __syncthreads();
                const int ub = (int)MISC[16];
                if (ub >= 1024) break;
                const int u = 1024 + ub;
                const int head = 8 + (((u & 255) >> 6) & 1) * 4 + ((u & 1023) >> 8);
                ATT_UNIT_SETUP
                att::attn_unit<true>(Qp, Pb + COL_KB + kv * HD, Pb + COL_VB + kv * HD, Zp, Yp, lat0, ctx0, q0, sink[kv * 4 + gq], false, (char*)lds);
            }
        }
#undef ATT_UNIT_SETUP
    }
    SEAM(5);
    if (IN(6)) REP(6) {
        pg8::Gemm g{Yb, W0out, MLAT, DM, DM, DM, DM, 1 << 20}; pg8::StaticOrder S; S.init(MLAT, DM, G, bx);
        pg8::EpiMk E{Tb, DM, 1 << 30, nullptr, nullptr, 0};
        pg8::gemm_phase<pg8::EpiMk, pg8::StaticOrder, true, true>((LAS unsigned char*)lds, g, S, E);
    }
    SEAM(6);
    if (IN(7)) REP(7) {
        for (int m = gw; m < MLAT; m += NGW) {
            const int b = m / SEQ; const float* m0 = mod + (size_t)b * 3 * DM; const float* m1 = mod + (size_t)(3 + b) * 3 * DM;
            postnorm_row<true>(Tb + (size_t)m * DM, x + (size_t)m * DM, args.in[7], m0 + 2 * DM, out + (size_t)m * DM, args.in[15], m1, m1 + DM, Hb + (size_t)m * DM, lane);
        }
    }
    SEAM(7);
    if (IN(8)) REP(8) {
        pg8::Gemm g{Hb, W1in, MLAT, ODD_IN, DM, DM, DM, 1 << 20}; pg8::StaticOrder S; S.init(MLAT, ODD_IN, G, bx);
        pg8::EpiMk E{Pb, ODD_IN, DM, nullptr, nullptr, 0};
        pg8::gemm_phase<pg8::EpiMk, pg8::StaticOrder, true, true>((LAS unsigned char*)lds, g, S, E);
    }
    SEAM(8);
    if (IN(9)) REP(9) {
        const int cg8 = (tid & 255) * 8, g = __builtin_amdgcn_readfirstlane(cg8 >> 9);
        for (int ch = bx; ch < MLAT / 16; ch += G) {
            const int m0 = ch * 16 + (tid >> 8) * 8, t0 = m0 & (SEQ - 1); const size_t base = (size_t)(m0 - t0);
            if (g == 0) pool_chunk<1>(Pb, Hb, base, t0, cg8); else if (g == 1) pool_chunk<2>(Pb, Hb, base, t0, cg8);
            else if (g == 2) pool_chunk<4>(Pb, Hb, base, t0, cg8); else pool_chunk<8>(Pb, Hb, base, t0, cg8);
        }
    }
    SEAM(9);
    if (IN(10)) REP(10) {
        pg8::Gemm g{Hb, Wpool, MLAT, DM, 512, DM, 512, 2}; pg8::StaticOrder S; S.init(MLAT, DM, G, bx);
        pg8::EpiMk E{Yb, DM, 1 << 30, args.in[19], Pb + DM, ODD_IN};
        pg8::gemm_phase<pg8::EpiMk, pg8::StaticOrder, true, true>((LAS unsigned char*)lds, g, S, E);
    }
    SEAM(10);
    if (IN(11)) REP(11) {
        pg8::Gemm g{Yb, W1out, MLAT, DM, DM, DM, DM, 1 << 20}; pg8::StaticOrder S; S.init(MLAT, DM, G, bx);
        pg8::EpiMk E{Tb, DM, 1 << 30, nullptr, nullptr, 0};
        pg8::gemm_phase<pg8::EpiMk, pg8::StaticOrder, true, true>((LAS unsigned char*)lds, g, S, E);
    }
    SEAM(11);
    if (IN(12)) {
        for (int m = gw; m < MLAT; m += NGW) {
            const int b = m / SEQ; const float* m1 = mod + (size_t)(3 + b) * 3 * DM;
            postnorm_row<false>(Tb + (size_t)m * DM, out + (size_t)m * DM, args.in[16], m1 + 2 * DM, out + (size_t)m * DM, nullptr, nullptr, nullptr, nullptr, lane);
        }
    }
#ifdef MK_XSYNC
    for (int i = 0; i < MK_XSYNC; ++i) xcd_barrier(bar);
#endif
#undef IN
#undef SEAM
}

constexpr int N_PHASES = 13;
#ifndef MK_PER_PHASE
#define MK_PER_PHASE 0
#endif
extern "C" void kernel_launch(void* const* d_in, const int* in_sizes, int n_in, void* d_out, int out_size, void* d_ws, size_t ws_size, hipStream_t stream) {
    static int grid = 0;
    if (grid == 0) {
        if (n_in != 21 || out_size != MLAT * DM || ws_size < WS_END) { fprintf(stderr, "kernel_launch: unexpected shapes (n_in %d out %d ws %zu)\n", n_in, out_size, ws_size); grid = -1; return; }
        int dev = 0, cus = 0, per_cu = 0;
        hipGetDevice(&dev); hipDeviceGetAttribute(&cus, hipDeviceAttributeMultiprocessorCount, dev);
        if (hipFuncSetAttribute((const void*)mk_fwd, hipFuncAttributeMaxDynamicSharedMemorySize, LDS_BYTES) != hipSuccess) { fprintf(stderr, "kernel_launch: hipFuncSetAttribute failed\n"); grid = -1; return; }
        if (hipOccupancyMaxActiveBlocksPerMultiprocessor(&per_cu, (const void*)mk_fwd, 512, LDS_BYTES) != hipSuccess || per_cu < 1) per_cu = 1;
        (void)hipGetLastError();
        grid = cus * per_cu;
    }
    if (grid < 0) return;
    (void)hipMemsetAsync((char*)d_ws + WS_BAR, 0, 4096 * 4, stream);
    Args a{};
    for (int i = 0; i < 21; ++i) a.in[i] = (const float*)d_in[i];
    a.out = (float*)d_out; a.ws = (unsigned char*)d_ws;
    for (int f = 0; f < 32; ++f) { const double inv = pow(10000.0, -(double)f / 32.0); a.cs1[f] = cos(inv); a.sn1[f] = sin(inv); }
#if MK_PER_PHASE
    for (int p = 0; p < N_PHASES; ++p) { a.ph_lo = p; a.ph_hi = p + 1; hipLaunchKernelGGL(mk_fwd, dim3(grid), dim3(512), LDS_BYTES, stream, a); }
#else
    a.ph_lo = 0; a.ph_hi = N_PHASES;
    void* kargs[] = {&a};
    hipError_t e = hipLaunchCooperativeKernel((const void*)mk_fwd, dim3(grid), dim3(512), kargs, LDS_BYTES, stream);
    if (e != hipSuccess) fprintf(stderr, "kernel_launch: cooperative launch failed: %s (grid %d)\n", hipGetErrorString(e), grid);
#endif
}
```
